# Optimizing an MI355X kernel written in HIP

```python
import math
import jax, jax.numpy as jnp
from jax import lax
import numpy as np

D_MODEL = 1024
BATCH = 16
SEQ = 4096
DEPTH = 2

CHUNK = 64
N_MIXERS = 2
MIX_WIDTH = D_MODEL // 2
SGU_CHUNK = 128
SGU_HEADS = 4
SGU_HEAD_DIM = MIX_WIDTH // SGU_HEADS
CONV_WIDTH = 3
N_MEM = 256
XA_HEADS = 4
XA_HEAD_DIM = MIX_WIDTH // XA_HEADS
N_EXPERTS = 16
N_GROUPS = 4
GROUP_SIZE = N_EXPERTS // N_GROUPS
TOP_K = 2
D_EXPERT = D_MODEL // 2
N_A = (DEPTH + 1) // 2
N_B = DEPTH // 2
ALPHA = (2 * DEPTH) ** 0.25
BETA = (8 * DEPTH) ** -0.25
LN_EPS = 1e-5

kernel_name = "hybrid_gmlp_shortconv_memxattn_grouped_moe"


def layer_norm(x, g, b):
    xf = x.astype(jnp.float32)
    mu = xf.mean(-1, keepdims=True)
    var = jnp.square(xf - mu).mean(-1, keepdims=True)
    y = (xf - mu) * lax.rsqrt(var + LN_EPS) * g.astype(jnp.float32) + b.astype(jnp.float32)
    return y.astype(x.dtype)


def spatial_gating(z, ln_g, ln_b, w_s, b_s):
    u, v = jnp.split(z, 2, axis=-1)
    v = layer_norm(v, ln_g, ln_b)
    bsz, seq, _ = v.shape
    v = v.reshape(bsz, seq // SGU_CHUNK, SGU_CHUNK, SGU_HEADS, SGU_HEAD_DIM)
    frame_chunk = jnp.arange(SGU_CHUNK) // CHUNK
    mask = frame_chunk[:, None] >= frame_chunk[None, :]
    w = jnp.where(mask[None], w_s, jnp.zeros_like(w_s))
    mixed = jnp.einsum('hij,bcjhd->bcihd', w, v) + b_s.T[None, None, :, :, None]
    return u * mixed.reshape(bsz, seq, MIX_WIDTH)


def short_conv_mixer(z, conv_w):
    bg, cg, xt = jnp.split(z, 3, axis=-1)
    h = cg * xt
    h = lax.conv_general_dilated(
        h, conv_w[:, None, :].astype(h.dtype), window_strides=(1,),
        padding=[(CONV_WIDTH - 1, 0)], dimension_numbers=('NWC', 'WIO', 'NWC'),
        feature_group_count=MIX_WIDTH)
    return bg * h


def memory_cross_attention(q, mem, w_kv):
    bsz, seq, _ = q.shape
    n_mem = mem.shape[1]
    k, v = jnp.split(mem @ w_kv, 2, axis=-1)
    q = q.reshape(bsz, seq, XA_HEADS, XA_HEAD_DIM)
    k = k.reshape(bsz, n_mem, XA_HEADS, XA_HEAD_DIM)
    v = v.reshape(bsz, n_mem, XA_HEADS, XA_HEAD_DIM)
    s = jnp.einsum('bshd,bmhd->bhsm', q, k).astype(jnp.float32) * (XA_HEAD_DIM ** -0.5)
    p = jax.nn.softmax(s, axis=-1).astype(v.dtype)
    o = jnp.einsum('bhsm,bmhd->bshd', p, v)
    return o.reshape(bsz, seq, MIX_WIDTH)


def grouped_moe(x, router_w, router_b, w_gate, w_up, w_down):
    bsz, seq, d = x.shape
    xt = x.reshape(-1, d)
    scores = jax.nn.sigmoid(jnp.dot(xt.astype(jnp.float32), router_w.astype(jnp.float32)))
    sel = scores + router_b.astype(jnp.float32)
    group_score = lax.top_k(sel.reshape(-1, N_GROUPS, GROUP_SIZE), TOP_K)[0].sum(-1)
    top_group = jnp.argmax(group_score, axis=-1)
    expert_group = jnp.arange(N_EXPERTS) // GROUP_SIZE
    in_group = expert_group[None, :] == top_group[:, None]
    _, idx = lax.top_k(jnp.where(in_group, sel, -jnp.inf), TOP_K)
    gate = jnp.take_along_axis(scores, idx, axis=-1)
    gate = gate / gate.sum(-1, keepdims=True)
    combine = jnp.einsum('tk,tke->te', gate,
                         jax.nn.one_hot(idx, N_EXPERTS, dtype=jnp.float32)).astype(x.dtype)
    out = jnp.zeros_like(xt)
    for e in range(N_EXPERTS):
        h = jax.nn.silu(xt @ w_gate[e]) * (xt @ w_up[e])
        out = out + combine[:, e:e + 1] * (h @ w_down[e])
    return out.reshape(bsz, seq, d)


def setup_inputs(seed: int = 0) -> dict:
    key = jax.random.key(seed)
    ks = jax.random.split(key, 20)
    d = D_MODEL

    def nrm(k, shape, scale):
        return jax.random.normal(k, shape, jnp.float32) * scale

    x = nrm(ks[0], (BATCH, SEQ, d), 1.0)
    mem = nrm(ks[1], (BATCH, N_MEM, d), 1.0)
    w_in_a = nrm(ks[2], (N_A, d, 3 * MIX_WIDTH), d ** -0.5)
    sgu_ln_g = 1.0 + nrm(ks[3], (N_A, MIX_WIDTH), 0.02)
    sgu_ln_b = nrm(ks[4], (N_A, MIX_WIDTH), 0.02)
    sgu_w = nrm(ks[5], (N_A, SGU_HEADS, SGU_CHUNK, SGU_CHUNK), SGU_CHUNK ** -0.5)
    sgu_b = 1.0 + nrm(ks[6], (N_A, SGU_HEADS, SGU_CHUNK), 0.02)
    w_in_b = nrm(ks[7], (N_B, d, 4 * MIX_WIDTH), d ** -0.5)
    conv_w = nrm(ks[8], (N_B, CONV_WIDTH, MIX_WIDTH), CONV_WIDTH ** -0.5)
    kv_scale = jnp.concatenate([jnp.ones((MIX_WIDTH,), jnp.float32),
                                jnp.full((MIX_WIDTH,), BETA, jnp.float32)]) * (d ** -0.5)
    w_kv = nrm(ks[9], (DEPTH, d, 2 * MIX_WIDTH), 1.0) * kv_scale
    w_out = nrm(ks[10], (DEPTH, 2 * MIX_WIDTH, d), BETA * (2 * MIX_WIDTH) ** -0.5)
    ln1_g = 1.0 + nrm(ks[11], (DEPTH, d), 0.02)
    ln1_b = nrm(ks[12], (DEPTH, d), 0.02)
    router_w = nrm(ks[13], (d, N_EXPERTS), d ** -0.5)
    router_b = nrm(ks[14], (N_EXPERTS,), 0.01)
    w_gate = nrm(ks[15], (DEPTH, N_EXPERTS, d, D_EXPERT), d ** -0.5)
    w_up = nrm(ks[16], (DEPTH, N_EXPERTS, d, D_EXPERT), d ** -0.5)
    w_down = nrm(ks[17], (DEPTH, N_EXPERTS, D_EXPERT, d), BETA * D_EXPERT ** -0.5)
    ln2_g = 1.0 + nrm(ks[18], (DEPTH, d), 0.02)
    ln2_b = nrm(ks[19], (DEPTH, d), 0.02)
    return {"x": x, "mem": mem, "w_in_a": w_in_a, "sgu_ln_g": sgu_ln_g, "sgu_ln_b": sgu_ln_b,
            "sgu_w": sgu_w, "sgu_b": sgu_b, "w_in_b": w_in_b, "conv_w": conv_w,
            "w_kv": w_kv, "w_out": w_out, "ln1_g": ln1_g, "ln1_b": ln1_b,
            "router_w": router_w, "router_b": router_b, "w_gate": w_gate, "w_up": w_up,
            "w_down": w_down, "ln2_g": ln2_g, "ln2_b": ln2_b}


def reference(x, mem, w_in_a, sgu_ln_g, sgu_ln_b, sgu_w, sgu_b, w_in_b, conv_w,
              w_kv, w_out, ln1_g, ln1_b, router_w, router_b, w_gate, w_up, w_down,
              ln2_g, ln2_b):
    for i in range(DEPTH):
        j = i // N_MIXERS
        if i % N_MIXERS == 0:
            z = x @ w_in_a[j]
            uv = jax.nn.gelu(z[..., :2 * MIX_WIDTH], approximate=False)
            tok = spatial_gating(uv, sgu_ln_g[j], sgu_ln_b[j], sgu_w[j], sgu_b[j])
            q = z[..., 2 * MIX_WIDTH:]
        else:
            z = x @ w_in_b[j]
            tok = short_conv_mixer(z[..., :3 * MIX_WIDTH], conv_w[j])
            q = z[..., 3 * MIX_WIDTH:]
        xa = memory_cross_attention(q, mem, w_kv[i])
        o = jnp.concatenate([tok, xa], axis=-1) @ w_out[i]
        x = layer_norm(ALPHA * x + o, ln1_g[i], ln1_b[i])
        f = grouped_moe(x, router_w, router_b, w_gate[i], w_up[i], w_down[i])
        x = layer_norm(ALPHA * x + f, ln2_g[i], ln2_b[i])
    return x
```

```cpp
#include <hip/hip_runtime.h>
#include <cstdio>
#include <cstdint>
#include <type_traits>

#define LAS __attribute__((address_space(3)))
typedef unsigned short bf16;
typedef short bf16x8 __attribute__((ext_vector_type(8)));
typedef float f32x4 __attribute__((ext_vector_type(4)));
typedef float f32x16 __attribute__((ext_vector_type(16)));
typedef unsigned u32x4 __attribute__((ext_vector_type(4)));
typedef unsigned u32x2 __attribute__((ext_vector_type(2)));
typedef float f32x2g __attribute__((ext_vector_type(2)));
typedef __bf16 bf16x2t __attribute__((ext_vector_type(2)));
typedef unsigned short u16x2 __attribute__((ext_vector_type(2)));

constexpr int T = 65536, D = 1024, MW = 512, SEQ = 4096, NBATCH = 16, NMEM = 256, NE = 16, DE = 512, NH = 4, HD = 128;
constexpr int NTOKMEM = NBATCH * NMEM;
constexpr float LN_EPS = 1e-5f;
constexpr float ALPHA = 1.41421356237f;
constexpr int MAXRT = 528;
constexpr float Y_SCALE = 16.f;

constexpr size_t MiB = 1u << 20;
constexpr size_t WS_CTL = 0, CTL_ZERO_BYTES = 1 * MiB;
constexpr size_t WS_WINA = 2 * MiB, WS_WINB = 5 * MiB, WS_WK = 9 * MiB, WS_WV = 11 * MiB, WS_WOUT = 13 * MiB, WS_WSGU = 17 * MiB;
constexpr size_t WS_WGU = 18 * MiB, WS_WD = 82 * MiB, WS_MEMB = 114 * MiB, WS_KMAT = 122 * MiB, WS_VT = 130 * MiB;
constexpr size_t WS_LIST = 138 * MiB, WS_GATES = 142 * MiB, WS_XB = 144 * MiB, WS_X1 = 272 * MiB, WS_H1 = 400 * MiB;
constexpr size_t WS_Z = 528 * MiB, WS_Y = WS_Z, WS_CAT = 784 * MiB, WS_HMOE = WS_CAT, WS_XQ = 920 * MiB  , WS_END = 984 * MiB;
constexpr size_t WS_CS = 1 * MiB;
constexpr size_t WS_XSCALE = 143 * MiB;
constexpr size_t WS_X1Q = 664 * MiB;
constexpr size_t WS_X1SCALE = 143 * MiB + 524288;
constexpr size_t WS_LSCL = 728 * MiB;
constexpr size_t WS_CSOUT = WS_CS + 163840;
constexpr size_t WS_CSCALE = 143 * MiB + 262144;
constexpr int CW_VBOUND = 12288;
constexpr int ROWSC_OFF = 139264;
constexpr size_t WS_CSD = WS_CS + 172032;
constexpr float Z_SCALE = 8.f;
constexpr float H_SCALE = 4.f;
constexpr size_t WS_CSGU = WS_CS + 16384;
typedef int i32x4 __attribute__((ext_vector_type(4)));
typedef int i32x8 __attribute__((ext_vector_type(8)));
constexpr int CW_CNT = 8192;

struct Ptrs {
    const float *x, *mem, *w_in_a, *sgu_ln_g, *sgu_ln_b, *sgu_w, *sgu_b, *w_in_b, *conv_w, *w_kv, *w_out, *ln1_g, *ln1_b, *router_w, *router_b, *w_gate, *w_up, *w_down, *ln2_g, *ln2_b;
    float* out; unsigned char* ws;
};

__device__ __forceinline__ unsigned char* fresh(unsigned char* p) { size_t z = 0; asm volatile("" : "+s"(z)); return p + z; }
__device__ __forceinline__ int freshi(int v) { asm volatile("" : "+s"(v)); return v; }
__device__ __forceinline__ unsigned f2bf(float f) { unsigned u = __builtin_bit_cast(unsigned, f); return (u + 0x7fffu + ((u >> 16) & 1u)) >> 16; }
__device__ __forceinline__ unsigned pk2(float lo, float hi) { return f2bf(lo) | (f2bf(hi) << 16); }
__device__ __forceinline__ float bf2f(unsigned short b) { return __builtin_bit_cast(float, (unsigned)b << 16); }
__device__ __forceinline__ float bflo(unsigned w) { return __builtin_bit_cast(float, w << 16); }
__device__ __forceinline__ float bfhi(unsigned w) { return __builtin_bit_cast(float, w & 0xffff0000u); }
__device__ __forceinline__ void unpack8(const u32x4 w, float* f) { f[0] = bflo(w.x); f[1] = bfhi(w.x); f[2] = bflo(w.y); f[3] = bfhi(w.y); f[4] = bflo(w.z); f[5] = bfhi(w.z); f[6] = bflo(w.w); f[7] = bfhi(w.w); }
__device__ __forceinline__ unsigned cvtpk2(float lo, float hi) { unsigned r; asm volatile("v_cvt_pk_bf16_f32 %0, %1, %2" : "=v"(r) : "v"(lo), "v"(hi)); return r; }
__device__ __forceinline__ u32x4 pack8(const float* f) { u32x4 w; w.x = cvtpk2(f[0], f[1]); w.y = cvtpk2(f[2], f[3]); w.z = cvtpk2(f[4], f[5]); w.w = cvtpk2(f[6], f[7]); return w; }
#define DPPF(v, ctrl) __builtin_bit_cast(float, __builtin_amdgcn_update_dpp(0, __builtin_bit_cast(int, (v)), (ctrl), 0xf, 0xf, false))
__device__ __forceinline__ float wave_sum(float v) {
    v += DPPF(v, 0xB1); v += DPPF(v, 0x4E); v += DPPF(v, 0x141); v += DPPF(v, 0x140);
    const int iv = __builtin_bit_cast(int, v);
    return (__builtin_bit_cast(float, __builtin_amdgcn_readlane(iv, 0)) + __builtin_bit_cast(float, __builtin_amdgcn_readlane(iv, 16))) + (__builtin_bit_cast(float, __builtin_amdgcn_readlane(iv, 32)) + __builtin_bit_cast(float, __builtin_amdgcn_readlane(iv, 48)));
}
__device__ __forceinline__ float wave_max(float v) {
    v = fmaxf(v, DPPF(v, 0xB1)); v = fmaxf(v, DPPF(v, 0x4E)); v = fmaxf(v, DPPF(v, 0x141)); v = fmaxf(v, DPPF(v, 0x140));
    const int iv = __builtin_bit_cast(int, v);
    return fmaxf(fmaxf(__builtin_bit_cast(float, __builtin_amdgcn_readlane(iv, 0)), __builtin_bit_cast(float, __builtin_amdgcn_readlane(iv, 16))), fmaxf(__builtin_bit_cast(float, __builtin_amdgcn_readlane(iv, 32)), __builtin_bit_cast(float, __builtin_amdgcn_readlane(iv, 48))));
}

__device__ __forceinline__ void transpose_item(const float* W, int ldn, int k0, int n0, bf16* WTrow0  , int K, LAS float* scr, int lane) {
#pragma unroll 8
    for (int i = 0; i < 32; ++i) { const int kk = 2 * i + (lane >> 5); scr[kk * 33 + (lane & 31)] = W[(size_t)(k0 + kk) * ldn + n0 + (lane & 31)]; }
    asm volatile("s_waitcnt lgkmcnt(0)" ::: "memory");
    const int c = lane & 7;
#pragma unroll
    for (int j = 0; j < 4; ++j) { const int n = (lane >> 3) + 8 * j; const LAS float* s = scr + (8 * c) * 33 + n;
        u32x4 o; o.x = pk2(s[0 * 33], s[1 * 33]); o.y = pk2(s[2 * 33], s[3 * 33]); o.z = pk2(s[4 * 33], s[5 * 33]); o.w = pk2(s[6 * 33], s[7 * 33]);
        *(u32x4*)(WTrow0 + (size_t)n * K + k0 + 8 * c) = o; }
    asm volatile("s_waitcnt lgkmcnt(0)" ::: "memory");
}
__device__ __forceinline__ int q8(float v) { int q = __float2int_rn(v); return q < -127 ? -127 : (q > 127 ? 127 : q); }
__device__ __forceinline__ unsigned pack4q(float a, float b, float c, float d) { const float M = 12582912.f;
    const unsigned ua = __builtin_bit_cast(unsigned, a + M), ub = __builtin_bit_cast(unsigned, b + M), uc = __builtin_bit_cast(unsigned, c + M), ud = __builtin_bit_cast(unsigned, d + M);
    return __builtin_amdgcn_perm(ub, ua, 0x0c0c0400u) | __builtin_amdgcn_perm(ud, uc, 0x04000c0cu); }
__device__ __forceinline__ unsigned pk4_fp8g(float a, float b, float c, float d) { int r = __builtin_amdgcn_cvt_pk_fp8_f32(a, b, 0, false); r = __builtin_amdgcn_cvt_pk_fp8_f32(c, d, r, true); return (unsigned)r; }
template <bool FP8 = false>
__device__ __forceinline__ void qtranspose_cols_wg(const float* W, int ldn, int n0, int K, signed char* dstrow0  , float* cs  , LAS float* scr, LAS float* part, int lane, int wave) {
    const int kw = K >> 3, kbeg = wave * kw, kr = lane >> 3, c4 = (lane & 7) * 4;
    f32x4 mx = (f32x4){0.f, 0.f, 0.f, 0.f};
#pragma unroll 4
    for (int k = kbeg; k < kbeg + kw; k += 8) { const f32x4 v = *(const f32x4*)(W + (size_t)(k + kr) * ldn + n0 + c4); mx.x = fmaxf(mx.x, fabsf(v.x)); mx.y = fmaxf(mx.y, fabsf(v.y)); mx.z = fmaxf(mx.z, fabsf(v.z)); mx.w = fmaxf(mx.w, fabsf(v.w)); }
#pragma unroll
    for (int o = 8; o < 64; o <<= 1) { mx.x = fmaxf(mx.x, __shfl_xor(mx.x, o)); mx.y = fmaxf(mx.y, __shfl_xor(mx.y, o)); mx.z = fmaxf(mx.z, __shfl_xor(mx.z, o)); mx.w = fmaxf(mx.w, __shfl_xor(mx.w, o)); }
    if (lane < 8) *(LAS f32x4*)(part + wave * 32 + c4) = mx;
    __syncthreads();
    const int n = lane >> 1; float cm = 0.f;
#pragma unroll
    for (int w = 0; w < 8; ++w) cm = fmaxf(cm, part[w * 32 + n]);
    const float scale = cm > 0.f ? cm * (FP8 ? 1.f / 256.f : 1.f / 127.f) : 1.f, invn = 1.f / scale;
    if (wave == 0 && (lane & 1) == 0) cs[n] = scale;
    for (int k0 = kbeg; k0 < kbeg + kw; k0 += 64) {
        f32x4 ld[8];
#pragma unroll
        for (int i = 0; i < 8; ++i) ld[i] = *(const f32x4*)(W + (size_t)(k0 + 8 * i + kr) * ldn + n0 + c4);
#pragma unroll
        for (int i = 0; i < 8; ++i) { LAS float* sp = scr + (8 * i + kr) * 33 + c4; sp[0] = ld[i].x; sp[1] = ld[i].y; sp[2] = ld[i].z; sp[3] = ld[i].w; }
        asm volatile("s_waitcnt lgkmcnt(0)" ::: "memory");
#pragma unroll
        for (int jj = 0; jj < 2; ++jj) { const int cidx = (lane & 1) * 2 + jj; const LAS float* sp = scr + (16 * cidx) * 33 + n;
            u32x4 o;
            if constexpr (FP8) { o.x = pk4_fp8g(sp[0] * invn, sp[33] * invn, sp[66] * invn, sp[99] * invn); o.y = pk4_fp8g(sp[132] * invn, sp[165] * invn, sp[198] * invn, sp[231] * invn);
                o.z = pk4_fp8g(sp[264] * invn, sp[297] * invn, sp[330] * invn, sp[363] * invn); o.w = pk4_fp8g(sp[396] * invn, sp[429] * invn, sp[462] * invn, sp[495] * invn); }
            else { o.x = pack4q(sp[0] * invn, sp[33] * invn, sp[66] * invn, sp[99] * invn); o.y = pack4q(sp[132] * invn, sp[165] * invn, sp[198] * invn, sp[231] * invn);
                o.z = pack4q(sp[264] * invn, sp[297] * invn, sp[330] * invn, sp[363] * invn); o.w = pack4q(sp[396] * invn, sp[429] * invn, sp[462] * invn, sp[495] * invn); }
            *(u32x4*)(dstrow0 + (size_t)n * K + k0 + 16 * cidx) = o; }
        asm volatile("s_waitcnt lgkmcnt(0)" ::: "memory");
    }
    __syncthreads();
}
constexpr int QIT_INA = 48, QIT_INB = 64, QIT_GU = 16 * 2 * 16  , QIT_OUT = 2 * 32, QIT_TOTAL = QIT_INA + QIT_INB + QIT_GU + QIT_OUT;
constexpr int IT_INA = 0, IT_INB = 0, IT_KV = 2 * 16 * 32, IT_OUT = 2 * 16 * 32, IT_G = 0, IT_U = 0, IT_DN = 32 * 8 * 32;
constexpr int IT_TOTAL = IT_INA + IT_INB + IT_KV + IT_OUT + IT_G + IT_U + IT_DN;

__device__ __forceinline__ void phase_prologue(const Ptrs& P, LAS unsigned char* lds, int c, int G) {
    int tid_ = threadIdx.x; asm volatile("" : "+v"(tid_));
    const int tid = tid_, lane = tid & 63, wave = tid >> 6, nw = blockDim.x >> 6;
    unsigned char* ws = fresh(P.ws);
    LAS float* scr = (LAS float*)(lds + wave * 8704);
    const int gw = c * nw + wave, NGW = G * nw;
    { LAS float* part = (LAS float*)(lds + 8 * 8704);
      for (int qi = c; qi < QIT_TOTAL; qi += G) {
        if (qi < QIT_INA) qtranspose_cols_wg(P.w_in_a, 1536, qi * 32, 1024, (signed char*)(ws + WS_WINA) + (size_t)(qi * 32) * 1024, (float*)(ws + WS_CS) + qi * 32, scr, part, lane, wave);
        else if (qi < QIT_INA + QIT_INB) { const int q2 = qi - QIT_INA, n0 = q2 * 32;
            int drow = n0; if (n0 >= 512 && n0 < 1536) { const int j = (n0 - 512) & 511, isx = n0 >= 1024; drow = 512 + 256 * (j >> 7) + 64 * ((j & 127) >> 5) + (isx ? 32 : 0); }
            qtranspose_cols_wg(P.w_in_b, 2048, n0, 1024, (signed char*)(ws + WS_WINB) + (size_t)drow * 1024, (float*)(ws + WS_CS) + 2048 + drow, scr, part, lane, wave); }
        else if (qi >= QIT_INA + QIT_INB + QIT_GU) { const int q4 = qi - QIT_INA - QIT_INB - QIT_GU, l = q4 >> 5, nb = q4 & 31;
            qtranspose_cols_wg(P.w_out + (size_t)l * 1024 * 1024, 1024, nb * 32, 1024, (signed char*)(ws + WS_WOUT) + (size_t)l * 1024 * 1024 + (size_t)(nb * 32) * 1024, (float*)(ws + WS_CSOUT) + l * 1024 + nb * 32, scr, part, lane, wave); }
        else { const int q3 = qi - QIT_INA - QIT_INB, le = q3 >> 5, up = (q3 >> 4) & 1, nb = q3 & 15, n0 = nb * 32, drow = (n0 >> 7) * 256 + (up ? 128 : 0) + (n0 & 127);
            qtranspose_cols_wg((up ? P.w_up : P.w_gate) + (size_t)le * 1024 * 512, 512, n0, 1024, (signed char*)(ws + WS_WGU) + (size_t)le * 1024 * 1024 + (size_t)drow * 1024, (float*)(ws + WS_CSGU) + le * 1024 + drow, scr, part, lane, wave); } } }
    for (int it = gw; it < IT_KV; it += NGW) {
        int r = it;
        if (r < IT_KV) { const int l = r / 512, q = r % 512, kb = q / 32, nb = q % 32; const int n0 = nb * 32;
            bf16* dst = (n0 < 512) ? (bf16*)(ws + WS_WK) + (size_t)(l * 512 + n0) * 1024 : (bf16*)(ws + WS_WV) + (size_t)(l * 512 + n0 - 512) * 1024;
            transpose_item(P.w_kv + (size_t)l * 1024 * 1024, 1024, kb * 64, n0, dst, 1024, scr, lane); }
    }
    const size_t gt = (size_t)c * blockDim.x + tid, NT = (size_t)G * blockDim.x;
    f32x4 na, nb, nc, nd; { const f32x4* xr = (const f32x4*)(P.x + (size_t)gw * D + lane * 16); na = xr[0]; nb = xr[1]; nc = xr[2]; nd = xr[3]; }
    for (size_t row = gw; row < (size_t)T; row += NGW) { const f32x4 a = na, b = nb, cc = nc, d = nd;
        { const size_t rn = row + NGW < (size_t)T ? row + NGW : row; const f32x4* xr = (const f32x4*)(P.x + rn * D + lane * 16); na = xr[0]; nb = xr[1]; nc = xr[2]; nd = xr[3]; }
        u32x4 o0, o1; o0.x = pk2(a.x, a.y); o0.y = pk2(a.z, a.w); o0.z = pk2(b.x, b.y); o0.w = pk2(b.z, b.w); o1.x = pk2(cc.x, cc.y); o1.y = pk2(cc.z, cc.w); o1.z = pk2(d.x, d.y); o1.w = pk2(d.z, d.w);
        u32x4* xbp = (u32x4*)(ws + WS_XB + (row * D + lane * 16) * 2); xbp[0] = o0; xbp[1] = o1;
        float mx = fmaxf(fmaxf(fmaxf(fabsf(a.x), fabsf(a.y)), fmaxf(fabsf(a.z), fabsf(a.w))), fmaxf(fmaxf(fabsf(b.x), fabsf(b.y)), fmaxf(fabsf(b.z), fabsf(b.w))));
        mx = fmaxf(mx, fmaxf(fmaxf(fmaxf(fabsf(cc.x), fabsf(cc.y)), fmaxf(fabsf(cc.z), fabsf(cc.w))), fmaxf(fmaxf(fabsf(d.x), fabsf(d.y)), fmaxf(fabsf(d.z), fabsf(d.w)))));
        mx = wave_max(mx); const float scale = mx > 0.f ? mx * (1.f / 127.f) : 1.f, inv = 1.f / scale;
        u32x4 q; q.x = pack4q(a.x * inv, a.y * inv, a.z * inv, a.w * inv); q.y = pack4q(b.x * inv, b.y * inv, b.z * inv, b.w * inv); q.z = pack4q(cc.x * inv, cc.y * inv, cc.z * inv, cc.w * inv); q.w = pack4q(d.x * inv, d.y * inv, d.z * inv, d.w * inv);
        *(u32x4*)(ws + WS_XQ + row * D + lane * 16) = q; if (lane == 0) ((float*)(ws + WS_XSCALE))[row] = scale; }
    for (size_t i = gt; i < (size_t)NTOKMEM * D / 8; i += NT) { const f32x4 a = ((const f32x4*)P.mem)[2 * i], b = ((const f32x4*)P.mem)[2 * i + 1];
        u32x4 o; o.x = pk2(a.x, a.y); o.y = pk2(a.z, a.w); o.z = pk2(b.x, b.y); o.w = pk2(b.z, b.w); ((u32x4*)(ws + WS_MEMB))[i] = o; }
    for (size_t i = gt; i < (size_t)NH * 128 * 128; i += NT) { const int hh = (int)(i >> 14), ii = (int)(i >> 7) & 127, pos = (int)i & 127, kb = pos >> 5, g = (pos >> 3) & 3, jj = pos & 7;
        const int j = 32 * kb + (jj < 4 ? 4 * g + jj : 16 + 4 * g + (jj - 4));
        const float v = ((ii >> 6) >= (j >> 6)) ? P.sgu_w[(size_t)(hh * 128 + ii) * 128 + j] : 0.f; ((bf16*)(ws + WS_WSGU))[i] = (bf16)f2bf(v * (1.f / Z_SCALE)); }
}

__device__ __forceinline__ void phase_prologue_b(const Ptrs& P, LAS unsigned char* lds, int c, int G) {
    int tid_ = threadIdx.x; asm volatile("" : "+v"(tid_));
    const int tid = tid_, lane = tid & 63, wave = tid >> 6, nw = blockDim.x >> 6;
    unsigned char* ws = fresh(P.ws);
    LAS float* scr = (LAS float*)(lds + wave * 8704);
    const int gw = c * nw + wave, NGW = G * nw;
    LAS float* part = (LAS float*)(lds + 8 * 8704);
    for (int qi = c; qi < 16 * 32; qi += G) { const int le = qi >> 5, nb = qi & 31;
        qtranspose_cols_wg<true>(P.w_down + (size_t)le * 512 * 1024, 1024, nb * 32, 512, (signed char*)(ws + WS_WD) + (size_t)le * 1024 * 512 + (size_t)(nb * 32) * 512, (float*)(ws + WS_CSD) + le * 1024 + nb * 32, scr, part, lane, wave); }
    (void)gw; (void)NGW; (void)tid;
}

__device__ __forceinline__ void late_convert(const Ptrs& P, LAS unsigned char* lds, int c, int G, int NT, bool down) {
    int tid_ = threadIdx.x; asm volatile("" : "+v"(tid_));
    const int tid = tid_, lane = tid & 63, wave = tid >> 6;
    unsigned char* ws = fresh(P.ws);
    LAS float* scr = (LAS float*)(lds + wave * 8704); LAS float* part = (LAS float*)(lds + 8 * 8704);
    const int units = NT * 4, rounds = (units + G - 1) / G, nextra = units - (rounds - 1) * G;
    int w0 = nextra, nwork = G - nextra; if (nwork < 64) { w0 = 0; nwork = G; }
    if (c < w0) return;
    for (int q = c - w0; q < 512; q += nwork) {
        if (!down) { const int q3 = 512 + q, le = q3 >> 5, up = (q3 >> 4) & 1, nb = q3 & 15, n0 = nb * 32, drow = (n0 >> 7) * 256 + (up ? 128 : 0) + (n0 & 127);
            qtranspose_cols_wg((up ? P.w_up : P.w_gate) + (size_t)le * 1024 * 512, 512, n0, 1024, (signed char*)(ws + WS_WGU) + (size_t)le * 1024 * 1024 + (size_t)drow * 1024, (float*)(ws + WS_CSGU) + le * 1024 + drow, scr, part, lane, wave); }
        else { const int qi = 512 + q, le = qi >> 5, nb = qi & 31;
            qtranspose_cols_wg<true>(P.w_down + (size_t)le * 512 * 1024, 1024, nb * 32, 512, (signed char*)(ws + WS_WD) + (size_t)le * 1024 * 512 + (size_t)(nb * 32) * 512, (float*)(ws + WS_CSD) + le * 1024 + nb * 32, scr, part, lane, wave); }
    }
}

__device__ __forceinline__ unsigned cvtpk(float lo, float hi) { unsigned r; asm volatile("v_cvt_pk_bf16_f32 %0, %1, %2" : "=v"(r) : "v"(lo), "v"(hi)); return r; }
__device__ __forceinline__ void phase_ln1_router(const Ptrs& P, LAS unsigned char* lds, int c, int G, int layer, bool dry) {
    int tid_ = threadIdx.x; asm volatile("" : "+v"(tid_));
    const int tid = tid_, lane = tid & 63, wave = tid >> 6, l15 = lane & 15, g = lane >> 4;
    unsigned char* ws = fresh(P.ws);
    LAS unsigned char* rwh = lds; LAS unsigned char* rwl = lds + 32768;
    LAS float* gam = (LAS float*)(lds + 65536); LAS float* bet = (LAS float*)(lds + 65536 + 4096);
    LAS int* hist = (LAS int*)(lds + 73728);
    LAS int* base = (LAS int*)(lds + 73728 + 64);
    LAS int* loc_e = (LAS int*)(lds + 73728 + 128);
    LAS int* loc_s = (LAS int*)(lds + 73728 + 128 + 2048);
    LAS float* lgt = (LAS float*)(lds + 73728 + 128 + 4096);
    LAS float* rsc = (LAS float*)(lds + 73728 + 128 + 4096 + 20480);
    const bf16* H1 = (const bf16*)(ws + WS_H1); bf16* X1 = (bf16*)(ws + WS_X1); (void)X1;
    unsigned* cnt = (unsigned*)(ws + WS_CTL) + CW_CNT + layer * 1024;
    unsigned* list = (unsigned*)(ws + WS_LIST); float* gates = (float*)(ws + WS_GATES);
    const int rb = c; (void)G;
    const float gv0 = P.ln1_g[layer * D + tid], gv1 = P.ln1_g[layer * D + 512 + tid], bv0 = P.ln1_b[layer * D + tid], bv1 = P.ln1_b[layer * D + 512 + tid];
    u32x4 raw[32];
    { const size_t row = (size_t)rb * 256 + wave * 32 + l15;
#pragma unroll
      for (int ks = 0; ks < 32; ++ks) raw[ks] = *(const u32x4*)(H1 + row * D + 32 * ks + 8 * g); }
    __builtin_amdgcn_sched_barrier(0);
#pragma unroll 4
    for (int k = 0; k < 32; ++k) { const int i = tid + 512 * k; const float w = P.router_w[i]; const int col = i >> 4, e = i & 15; const unsigned hb = f2bf(w); const float hf = __builtin_bit_cast(float, hb << 16);
        const int off = e * 2048 + ((((col >> 3) ^ e)) << 4) + (col & 7) * 2; *(LAS unsigned short*)(rwh + off) = (unsigned short)hb; *(LAS unsigned short*)(rwl + off) = (unsigned short)f2bf(w - hf); }
    gam[tid] = gv0; gam[512 + tid] = gv1; bet[tid] = bv0; bet[512 + tid] = bv1;
    if (tid < 16) hist[tid] = 0;
    __syncthreads();
    float gmax = 0.f, bmax = 0.f;
#pragma unroll
    for (int j = 0; j < 16; ++j) { gmax = fmaxf(gmax, fabsf(gam[lane * 16 + j])); bmax = fmaxf(bmax, fabsf(bet[lane * 16 + j])); }
    gmax = wave_max(gmax); bmax = wave_max(bmax);
    {
        auto group = [&](auto pf, const int grp) {
            constexpr bool PF = decltype(pf)::value;
            int lane_g = lane; asm volatile("" : "+v"(lane_g)); const int l15 = lane_g & 15, g = lane_g >> 4;
            const int rl0 = wave * 32 + grp * 16; const size_t row = (size_t)rb * 256 + rl0 + l15;
            float s1a = 0.f, s1b = 0.f, s2a = 0.f, s2b = 0.f; u16x2 mxa = (u16x2){0, 0}, mxb = (u16x2){0, 0};
            const bf16x2t ones2 = __builtin_bit_cast(bf16x2t, 0x3f803f80u);
#pragma unroll
            for (int ks = 0; ks < 32; ++ks) { const unsigned w0 = raw[ks].x, w1 = raw[ks].y, w2 = raw[ks].z, w3 = raw[ks].w;
                const bf16x2t p0 = __builtin_bit_cast(bf16x2t, w0), p1 = __builtin_bit_cast(bf16x2t, w1), p2 = __builtin_bit_cast(bf16x2t, w2), p3 = __builtin_bit_cast(bf16x2t, w3);
                s1a = __builtin_amdgcn_fdot2_f32_bf16(p0, ones2, s1a, false); s1b = __builtin_amdgcn_fdot2_f32_bf16(p1, ones2, s1b, false); s1a = __builtin_amdgcn_fdot2_f32_bf16(p2, ones2, s1a, false); s1b = __builtin_amdgcn_fdot2_f32_bf16(p3, ones2, s1b, false);
                s2a = __builtin_amdgcn_fdot2_f32_bf16(p0, p0, s2a, false); s2b = __builtin_amdgcn_fdot2_f32_bf16(p1, p1, s2b, false); s2a = __builtin_amdgcn_fdot2_f32_bf16(p2, p2, s2a, false); s2b = __builtin_amdgcn_fdot2_f32_bf16(p3, p3, s2b, false);
                mxa = __builtin_elementwise_max(mxa, __builtin_bit_cast(u16x2, w0 & 0x7fff7fffu)); mxb = __builtin_elementwise_max(mxb, __builtin_bit_cast(u16x2, w1 & 0x7fff7fffu));
                mxa = __builtin_elementwise_max(mxa, __builtin_bit_cast(u16x2, w2 & 0x7fff7fffu)); mxb = __builtin_elementwise_max(mxb, __builtin_bit_cast(u16x2, w3 & 0x7fff7fffu)); }
            float s1 = s1a + s1b, s2 = s2a + s2b; const unsigned mxw = __builtin_bit_cast(unsigned, __builtin_elementwise_max(mxa, mxb)); float amax = fmaxf(bflo(mxw), bfhi(mxw));
            s1 += __shfl_xor(s1, 16); s1 += __shfl_xor(s1, 32); s2 += __shfl_xor(s2, 16); s2 += __shfl_xor(s2, 32);
            amax = fmaxf(amax, __shfl_xor(amax, 16)); amax = fmaxf(amax, __shfl_xor(amax, 32));
            const float mean = s1 * (1.f / D); const float rstd = rsqrtf(fmaxf(s2 * (1.f / D) - mean * mean, 0.f) + LN_EPS); const float nmr = -mean * rstd;
            const float amb = gmax * rstd * (amax + fabsf(mean)) + bmax; const float qscale = amb > 0.f ? amb * (1.f / 127.f) : 1.f, qinv = 1.f / qscale;
            if (g == 0) { rsc[rl0 + l15] = qscale; ((float*)(ws + WS_X1SCALE))[row] = qscale; }
            signed char* XQ1 = (signed char*)(ws + WS_X1Q);
            f32x4 acc = (f32x4){0.f, 0.f, 0.f, 0.f};
#pragma unroll
            for (int ks = 0; ks < 32; ++ks) {
                if (PF || (ks & 1) == 0) __builtin_amdgcn_sched_barrier(0);
                u32x4 rk = raw[ks]; asm volatile("" : "+v"(rk));
                if (PF) raw[ks] = *(const u32x4*)(H1 + (row + 16) * D + 32 * ks + 8 * g);
                float v[8]; unpack8(rk, v);
                const f32x4 g0 = *(const LAS f32x4*)(gam + 32 * ks + 8 * g), g1 = *(const LAS f32x4*)(gam + 32 * ks + 8 * g + 4), b0 = *(const LAS f32x4*)(bet + 32 * ks + 8 * g), b1 = *(const LAS f32x4*)(bet + 32 * ks + 8 * g + 4);
                float x[8];
#pragma unroll
                for (int j = 0; j < 8; ++j) { const float gj = j < 4 ? g0[j & 3] : g1[j & 3], bj = j < 4 ? b0[j & 3] : b1[j & 3]; x[j] = (v[j] * rstd + nmr) * gj + bj; }
                { u32x2 qw; qw.x = pack4q(x[0] * qinv, x[1] * qinv, x[2] * qinv, x[3] * qinv); qw.y = pack4q(x[4] * qinv, x[5] * qinv, x[6] * qinv, x[7] * qinv); *(u32x2*)(XQ1 + row * D + 32 * ks + 8 * g) = qw; }
                u32x4 hw; hw.x = cvtpk(x[0], x[1]); hw.y = cvtpk(x[2], x[3]); hw.z = cvtpk(x[4], x[5]); hw.w = cvtpk(x[6], x[7]);
                float hf[8]; unpack8(hw, hf);
                u32x4 lw; lw.x = cvtpk(x[0] - hf[0], x[1] - hf[1]); lw.y = cvtpk(x[2] - hf[2], x[3] - hf[3]); lw.z = cvtpk(x[4] - hf[4], x[5] - hf[5]); lw.w = cvtpk(x[6] - hf[6], x[7] - hf[7]);
                const int boff = l15 * 2048 + (((4 * ks + g) ^ l15) << 4);
                const bf16x8 bh = *(const LAS bf16x8*)(rwh + boff), bl = *(const LAS bf16x8*)(rwl + boff);
                const bf16x8 ah = __builtin_bit_cast(bf16x8, hw), al = __builtin_bit_cast(bf16x8, lw);
                acc = __builtin_amdgcn_mfma_f32_16x16x32_bf16(ah, bh, acc, 0, 0, 0);
                acc = __builtin_amdgcn_mfma_f32_16x16x32_bf16(ah, bl, acc, 0, 0, 0);
                acc = __builtin_amdgcn_mfma_f32_16x16x32_bf16(al, bh, acc, 0, 0, 0);
            }
#pragma unroll
            for (int r = 0; r < 4; ++r) lgt[(rl0 + 4 * g + r) * 20 + l15] = acc[r];
        };
        group(std::true_type{}, 0);
        __builtin_amdgcn_sched_barrier(0);
        group(std::false_type{}, 1);
        __syncthreads();
        if (tid < 256) {
            const int rl = tid; const size_t row = (size_t)rb * 256 + rl;
            float sc[16], se[16];
#pragma unroll
            for (int q4 = 0; q4 < 4; ++q4) { const f32x4 lv = *(const LAS f32x4*)(lgt + rl * 20 + 4 * q4); const f32x4 rbv = ((const f32x4*)P.router_b)[q4];
#pragma unroll
                for (int k = 0; k < 4; ++k) { const float scv = 1.f / (1.f + __expf(-lv[k])); sc[4 * q4 + k] = scv; se[4 * q4 + k] = scv + rbv[k]; } }
            int bg = 0; float bgs = -3.0e38f;
#pragma unroll
            for (int gq = 0; gq < 4; ++gq) { const float a = se[4 * gq], b = se[4 * gq + 1], cc = se[4 * gq + 2], d = se[4 * gq + 3];
                const float mx = fmaxf(fmaxf(a, b), fmaxf(cc, d));
                const float lo1 = fminf(a, b), hi1 = fmaxf(a, b), lo2 = fminf(cc, d), hi2 = fmaxf(cc, d); const float second = fmaxf(fminf(hi1, hi2), fmaxf(lo1, lo2));
                const float gs = mx + second; if (gs > bgs) { bgs = gs; bg = gq; } }
            float s0 = 0.f, s1 = 0.f, s2 = 0.f, s3 = 0.f, c0 = 0.f, c1 = 0.f, c2 = 0.f, c3 = 0.f;
#pragma unroll
            for (int gq = 0; gq < 4; ++gq) if (bg == gq) { s0 = se[4 * gq]; s1 = se[4 * gq + 1]; s2 = se[4 * gq + 2]; s3 = se[4 * gq + 3]; c0 = sc[4 * gq]; c1 = sc[4 * gq + 1]; c2 = sc[4 * gq + 2]; c3 = sc[4 * gq + 3]; }
            int i0 = 0; float m0 = s0; if (s1 > m0) { m0 = s1; i0 = 1; } if (s2 > m0) { m0 = s2; i0 = 2; } if (s3 > m0) { m0 = s3; i0 = 3; }
            int i1 = -1; float m1 = -3.0e38f;
            if (i0 != 0 && s0 > m1) { m1 = s0; i1 = 0; } if (i0 != 1 && s1 > m1) { m1 = s1; i1 = 1; } if (i0 != 2 && s2 > m1) { m1 = s2; i1 = 2; } if (i0 != 3 && s3 > m1) { m1 = s3; i1 = 3; }
            const float sc0 = i0 == 0 ? c0 : i0 == 1 ? c1 : i0 == 2 ? c2 : c3, sc1 = i1 == 0 ? c0 : i1 == 1 ? c1 : i1 == 2 ? c2 : c3;
            const float inv = 1.f / (sc0 + sc1);
            if (!dry) { const int e0 = bg * 4 + i0, e1 = bg * 4 + i1;
                const int sl0 = __hip_atomic_fetch_add(hist + e0, 1, __ATOMIC_RELAXED, __HIP_MEMORY_SCOPE_WORKGROUP), sl1 = __hip_atomic_fetch_add(hist + e1, 1, __ATOMIC_RELAXED, __HIP_MEMORY_SCOPE_WORKGROUP);
                loc_e[2 * rl] = e0; loc_s[2 * rl] = sl0; loc_e[2 * rl + 1] = e1; loc_s[2 * rl + 1] = sl1;
                *(f32x2g*)(gates + row * 2) = (f32x2g){sc0 * inv, sc1 * inv}; }
        }
        __syncthreads();
        if (tid < 16 && !dry) base[tid] = (int)atomicAdd(&cnt[64 * tid], (unsigned)hist[tid]);
        __syncthreads();
        if (!dry) { const int e = loc_e[tid]; const size_t li = (size_t)e * T + base[e] + loc_s[tid]; list[li] = (unsigned)(rb * 512 + tid); ((float*)(ws + WS_LSCL))[li] = rsc[tid >> 1]; }
        __syncthreads();
        if (tid < 16) hist[tid] = 0;
        __syncthreads();
    }
}

__device__ __forceinline__ void unpack_fp8x8(const u32x2 w, float* f) {
    const auto l0 = __builtin_amdgcn_cvt_pk_f32_fp8((int)w.x, false); const auto h0 = __builtin_amdgcn_cvt_pk_f32_fp8((int)w.x, true); const auto l1 = __builtin_amdgcn_cvt_pk_f32_fp8((int)w.y, false); const auto h1 = __builtin_amdgcn_cvt_pk_f32_fp8((int)w.y, true);
    f[0] = l0[0]; f[1] = l0[1]; f[2] = h0[0]; f[3] = h0[1]; f[4] = l1[0]; f[5] = l1[1]; f[6] = h1[0]; f[7] = h1[1];
}
__device__ __forceinline__ void unpack_fp8x16(const u32x4 w, float* f) {
    const unsigned ww[4] = {w.x, w.y, w.z, w.w};
#pragma unroll
    for (int k = 0; k < 4; ++k) { const auto lo = __builtin_amdgcn_cvt_pk_f32_fp8((int)ww[k], false); const auto hi = __builtin_amdgcn_cvt_pk_f32_fp8((int)ww[k], true); f[4 * k] = lo[0]; f[4 * k + 1] = lo[1]; f[4 * k + 2] = hi[0]; f[4 * k + 3] = hi[1]; }
}
__device__ __forceinline__ void phase_ln2(const Ptrs& P, int c, int G, int layer) {
    int tid_ = threadIdx.x; asm volatile("" : "+v"(tid_));
    const int tid = tid_, lane = tid & 63, wave = tid >> 6, nw = blockDim.x >> 6;
    unsigned char* ws = fresh(P.ws);
    const unsigned char* X1Q = (const unsigned char*)(ws + WS_X1Q); const float* X1S = (const float*)(ws + WS_X1SCALE); const unsigned char* Y8 = (const unsigned char*)(ws + WS_Y); const float* gates = (const float*)(ws + WS_GATES);
    bf16* XB = (bf16*)(ws + WS_XB);
    const float* g2 = P.ln2_g + layer * D; const float* b2 = P.ln2_b + layer * D;
    float gg[16], bb[16];
#pragma unroll
    for (int j = 0; j < 16; ++j) { gg[j] = g2[lane * 16 + j]; bb[j] = b2[lane * 16 + j]; }
    const size_t rstep = (size_t)nw, rend = (size_t)(c + 1) * 256; size_t row = (size_t)c * 256 + wave; (void)G;
    u32x4 nx0 = *(const u32x4*)(X1Q + row * D + lane * 16), ny0 = *(const u32x4*)(Y8 + (row * 2) * 1024 + lane * 16), ny1 = *(const u32x4*)(Y8 + (row * 2 + 1) * 1024 + lane * 16);
    f32x2g ngt = *(const f32x2g*)(gates + row * 2); float nxs = X1S[row];
    for (; row < rend; row += rstep) {
        float v[16], a[16], b[16];
        const u32x4 cx0 = nx0, cy0 = ny0, cy1 = ny1; const f32x2g cgt = ngt; const float cxs = nxs;
        { const size_t rn = row + rstep < rend ? row + rstep : row;
          nx0 = *(const u32x4*)(X1Q + rn * D + lane * 16); ny0 = *(const u32x4*)(Y8 + (rn * 2) * 1024 + lane * 16); ny1 = *(const u32x4*)(Y8 + (rn * 2 + 1) * 1024 + lane * 16);
          ngt = *(const f32x2g*)(gates + rn * 2); nxs = X1S[rn]; }
        unpack_fp8x16(cy0, a); unpack_fp8x16(cy1, b);
        {
            const unsigned wq[4] = {cx0.x ^ 0x80808080u, cx0.y ^ 0x80808080u, cx0.z ^ 0x80808080u, cx0.w ^ 0x80808080u}; const float as = ALPHA * cxs, ao = -128.f * as;
#pragma unroll
            for (int k = 0; k < 4; ++k) { v[4 * k] = (float)(wq[k] & 255u) * as + ao; v[4 * k + 1] = (float)((wq[k] >> 8) & 255u) * as + ao; v[4 * k + 2] = (float)((wq[k] >> 16) & 255u) * as + ao; v[4 * k + 3] = (float)(wq[k] >> 24) * as + ao; } }
        const float ga = cgt[0] * (1.f / Y_SCALE), gb = cgt[1] * (1.f / Y_SCALE);
        float s = 0.f;
#pragma unroll
        for (int j = 0; j < 16; ++j) { v[j] = v[j] + (ga * a[j] + gb * b[j]); s += v[j]; }
        const float mean = wave_sum(s) * (1.f / D); float q = 0.f;
#pragma unroll
        for (int j = 0; j < 16; ++j) { v[j] -= mean; q += v[j] * v[j]; }
        const float rstd = rsqrtf(wave_sum(q) * (1.f / D) + LN_EPS);
#pragma unroll
        for (int j = 0; j < 16; ++j) v[j] = v[j] * rstd * gg[j] + bb[j];
        if (layer == 0) { *(u32x4*)(XB + row * D + lane * 16) = pack8(v); *(u32x4*)(XB + row * D + lane * 16 + 8) = pack8(v + 8);
            float mx = 0.f;
#pragma unroll
            for (int j = 0; j < 16; ++j) mx = fmaxf(mx, fabsf(v[j]));
            mx = wave_max(mx); const float scale = mx > 0.f ? mx * (1.f / 127.f) : 1.f, inv = 1.f / scale;
            u32x4 q; q.x = pack4q(v[0] * inv, v[1] * inv, v[2] * inv, v[3] * inv); q.y = pack4q(v[4] * inv, v[5] * inv, v[6] * inv, v[7] * inv); q.z = pack4q(v[8] * inv, v[9] * inv, v[10] * inv, v[11] * inv); q.w = pack4q(v[12] * inv, v[13] * inv, v[14] * inv, v[15] * inv);
            *(u32x4*)(ws + WS_XQ + row * D + lane * 16) = q; if (lane == 0) ((float*)(ws + WS_XSCALE))[row] = scale; }
        else { float* o = P.out + row * D + lane * 16; *(f32x4*)o = (f32x4){v[0], v[1], v[2], v[3]}; *(f32x4*)(o + 4) = (f32x4){v[4], v[5], v[6], v[7]};
               *(f32x4*)(o + 8) = (f32x4){v[8], v[9], v[10], v[11]}; *(f32x4*)(o + 12) = (f32x4){v[12], v[13], v[14], v[15]}; }
    }
}

__device__ __forceinline__ void conv_unit(const Ptrs& P, LAS unsigned char* lds, int unit, float vb) {
    const int tid = threadIdx.x, lane = tid & 63, wave = tid >> 6;
    unsigned char* wsc = fresh(P.ws); const unsigned char* Z = (const unsigned char*)(wsc + WS_Z); signed char* CATQ = (signed char*)(wsc + WS_CAT); LAS float* rowsc = (LAS float*)(lds + ROWSC_OFF);
    float w0[8], w1[8], w2[8];
#pragma unroll
    for (int j = 0; j < 8; ++j) { const float zz = 1.f / (Z_SCALE * Z_SCALE); w0[j] = P.conv_w[lane * 8 + j] * zz; w1[j] = P.conv_w[512 + lane * 8 + j] * zz; w2[j] = P.conv_w[1024 + lane * 8 + j] * zz; }
    const int t0 = unit * 128 + wave * 16;
    float hm2[8], hm1[8];
#pragma unroll
    for (int j = 0; j < 8; ++j) { hm2[j] = 0.f; hm1[j] = 0.f; }
    if ((t0 & (SEQ - 1)) != 0) {
        unpack_fp8x8(*(const u32x2*)(Z + (size_t)(t0 - 2) * 1536 + 512 + lane * 8), hm2);
        unpack_fp8x8(*(const u32x2*)(Z + (size_t)(t0 - 1) * 1536 + 512 + lane * 8), hm1);
    }
#pragma unroll 1
    for (int tb = t0; tb < t0 + 16; tb += 4) {
        u32x2 rb_[4], rh_[4];
#pragma unroll
        for (int k = 0; k < 4; ++k) { const unsigned char* zr = Z + (size_t)(tb + k) * 1536 + lane * 8; rb_[k] = *(const u32x2*)zr; rh_[k] = *(const u32x2*)(zr + 512); }
#pragma unroll
        for (int k = 0; k < 4; ++k) { float bgv[8], hv[8], o[8]; unpack_fp8x8(rb_[k], bgv); unpack_fp8x8(rh_[k], hv);
#pragma unroll
            for (int j = 0; j < 8; ++j) { const float h = hv[j]; o[j] = bgv[j] * (w0[j] * hm2[j] + w1[j] * hm1[j] + w2[j] * h); hm2[j] = hm1[j]; hm1[j] = h; }
            float mx = 0.f;
#pragma unroll
            for (int j = 0; j < 8; ++j) mx = fmaxf(mx, fabsf(o[j]));
            mx = fmaxf(wave_max(mx), vb); const float scale = mx > 0.f ? mx * (1.f / 127.f) : 1.f, inv = 1.f / scale;
            u32x2 q; q.x = pack4q(o[0] * inv, o[1] * inv, o[2] * inv, o[3] * inv); q.y = pack4q(o[4] * inv, o[5] * inv, o[6] * inv, o[7] * inv);
            *(u32x2*)(CATQ + (size_t)(tb + k) * D + lane * 8) = q;
            if (lane == 0) { ((float*)(wsc + WS_CSCALE))[tb + k] = scale; rowsc[(tb + k) & 255] = scale; } }
    }
}

namespace pg8 {
constexpr int BM = 256, BK = 64, HALF = 128, HTB = HALF * BK * 2, STAGE_BYTES = 8 * HTB, NXCD = 8, WGM = 8;
constexpr int META_OFF = STAGE_BYTES, META_SLOT = 3072;
constexpr int TAB_OFF = META_OFF + 3 * META_SLOT;
__host__ __device__ __forceinline__ int lds_byte(int r, int c) { const int st = (r >> 4) * 2 + (c >> 5), rr = r & 15, cc = c & 31, ob = rr * 64 + cc * 2; return st * 1024 + (ob ^ (((ob >> 9) & 1) << 5)); }
__host__ __device__ __forceinline__ void stage_rc(int b, int& R, int& C) { const int st = b / 1024, sb = b % 1024, swz = sb ^ (((sb >> 9) & 1) << 5); R = (st >> 1) * 16 + swz / 64; C = (st & 1) * 32 + (swz % 64) / 2; }
__host__ __device__ __forceinline__ int perm32(int rho) { const int n = rho >> 4, i = rho & 15; return 8 * (i >> 2) + 4 * n + (i & 3); }

struct Unit { int pm, pn; const char* A; const char* B; bf16* O; int ldc; int nvalid; const unsigned* meta; const float* rs; const float* cs; };

__device__ __forceinline__ bool static_tile(int i, int G, int c, int nM, int nN, int& pm, int& pn) {
    const int nwg = nM * nN; const long L = (long)i * G + c; if (L >= nwg) return false;
    int wgid = (int)L; { const int q = nwg / NXCD, r = nwg % NXCD, xcd = wgid % NXCD, off = wgid / NXCD; wgid = (xcd < r ? xcd * (q + 1) : r * (q + 1) + (xcd - r) * q) + off; }
    const int nig = WGM * nN, gid = wgid / nig, fm = gid * WGM, gsz = (nM - fm) < WGM ? (nM - fm) : WGM;
    pm = fm + ((wgid % nig) % gsz); pn = (wgid % nig) / gsz; return true;
}
struct SchedPlain {
    const char* A; const char* B; bf16* O; int nM, nN, pb, ldc, G, c; bf16* dummyO; const float* rs; const float* cs; bool panel;
    __device__ __forceinline__ bool next(int i, Unit& u) const { int pm, pn; if (panel) { if (i >= nN) return false; pm = c; pn = i; } else if (!static_tile(i, G, c, nM, nN, pm, pn)) return false;
        u.pm = pm; u.pn = pn; u.A = A + (size_t)pm * BM * pb; u.B = B + (size_t)pn * BM * pb; u.O = O; u.ldc = ldc; u.nvalid = 256; u.meta = nullptr; u.rs = rs + pm * BM; u.cs = cs + pn * BM;
        if (dummyO) { u.pm = c; u.pn = 0; u.O = dummyO; u.ldc = 256; } return true; }
};
struct SchedKV {
    const char* memb; const char* wk; const char* wv; bf16* kmat; bf16* vt; int G, c;
    __device__ __forceinline__ bool next(int i, Unit& u) const { const int L = i * G + c; if (L >= 128) return false; u.nvalid = 256; u.meta = nullptr; u.rs = nullptr; u.cs = nullptr;
        if (L < 64) { u.pm = L >> 2; u.pn = L & 3; u.A = memb + (size_t)u.pm * BM * 2048; u.B = wk + (size_t)u.pn * BM * 2048; u.O = kmat; u.ldc = 1024; }
        else { const int l2 = L - 64; u.pm = l2 >> 4; u.pn = l2 & 15; u.A = wv + (size_t)u.pm * BM * 2048; u.B = memb + (size_t)u.pn * BM * 2048; u.O = vt; u.ldc = 4096; }
        return true; }
};
struct SchedMoE {
    LAS unsigned char* lds; const char* A; const char* W; size_t wexp  ; int pb; bf16* O; int ldc; const unsigned* list; int NT, G, c; bool gatherA; const float* lscl; const float* csw  ;
    __device__ __forceinline__ bool next(int i, Unit& u) const { int pm, pn; if (!static_tile(i, G, c, NT, 4, pm, pn)) return false;
        const int lane = threadIdx.x & 63; const LAS int* tab = (const LAS int*)(lds + TAB_OFF);
        const int tsv = tab[lane & 15], cv = tab[16 + (lane & 15)];
        const unsigned long long m = __ballot(tsv <= pm) & 0xffffull; const int e = 63 - __builtin_clzll(m);
        const int ts = __builtin_amdgcn_readlane(tsv, e), ce = __builtin_amdgcn_readlane(cv, e); const int j = pm - ts; int nv = ce - 256 * j; nv = nv > 256 ? 256 : nv;
        u.pm = pm; u.pn = pn; u.nvalid = nv; u.meta = list + (size_t)e * T + 256 * j; u.O = O; u.ldc = ldc; u.rs = lscl + (size_t)e * T + 256 * j; u.cs = csw + e * 1024 + pn * BM;
        u.A = gatherA ? A : A + (size_t)pm * BM * pb; u.B = W + (size_t)e * wexp + (size_t)pn * BM * pb; return true; }
};
__device__ __forceinline__ int moe_tables(LAS unsigned char* lds, const unsigned* cnt) {
    const int lane = threadIdx.x & 63;
    const unsigned myc = __hip_atomic_load(cnt + 64 * (lane & 15), __ATOMIC_RELAXED, __HIP_MEMORY_SCOPE_AGENT);
    int start = 0; LAS int* tab = (LAS int*)(lds + TAB_OFF);
#pragma unroll
    for (int e = 0; e < 16; ++e) { const int ce = __builtin_amdgcn_readlane((int)myc, e); if (threadIdx.x == 0) { tab[e] = start; tab[16 + e] = ce; } start += (ce + 255) >> 8; }
    __syncthreads();
    return start;
}

__device__ __forceinline__ unsigned cvt_pk_bf16(float lo, float hi) { unsigned r; asm volatile("v_cvt_pk_bf16_f32 %0, %1, %2" : "=v"(r) : "v"(lo), "v"(hi)); return r; }
typedef float f32x2 __attribute__((ext_vector_type(2)));
__device__ __forceinline__ f32x2 gelu_pk(f32x2 v) {
    const f32x2 av = __builtin_elementwise_abs(v), d = av * 0.2316418882f + 1.0f;
    f32x2 t; t.x = __builtin_amdgcn_rcpf(d.x); t.y = __builtin_amdgcn_rcpf(d.y);
    f32x2 q = t * 0.5307027145f + (-0.7265760135f); q = q * t + 0.7107068705f; q = q * t + (-0.142248368f); q = q * t + 0.127414796f; q = q * t;
    const f32x2 s = (v * v) * (-0.72134752044f);
    f32x2 e; e.x = __builtin_amdgcn_exp2f(s.x); e.y = __builtin_amdgcn_exp2f(s.y);
    const f32x2 m = v * (q * e), r = v - m;
    f32x2 o; o.x = v.x < 0.f ? m.x : r.x; o.y = v.y < 0.f ? m.y : r.y; return o;
}
__device__ __forceinline__ unsigned ror8u(unsigned v) { return (unsigned)__builtin_amdgcn_update_dpp(0, (int)v, 0x128, 0xf, 0xf, false); }
__device__ __forceinline__ float ror8f(float v) { return __builtin_bit_cast(float, __builtin_amdgcn_update_dpp(0, __builtin_bit_cast(int, v), 0x128, 0xf, 0xf, false)); }
__device__ __forceinline__ void xchg_pk(const u32x4 P0, const u32x4 P1, bool lo, u32x4& S1, u32x4& S2) {
    u32x4 X, Y; X.x = lo ? P1.x : P0.x; X.y = lo ? P1.y : P0.y; X.z = lo ? P1.z : P0.z; X.w = lo ? P1.w : P0.w;
    Y.x = ror8u(X.x); Y.y = ror8u(X.y); Y.z = ror8u(X.z); Y.w = ror8u(X.w);
    S1.x = lo ? P0.x : Y.x; S1.y = lo ? P0.y : Y.y; S1.z = lo ? P0.z : Y.z; S1.w = lo ? P0.w : Y.w;
    S2.x = lo ? Y.x : P1.x; S2.y = lo ? Y.y : P1.y; S2.z = lo ? Y.z : P1.z; S2.w = lo ? Y.w : P1.w;
}
__device__ __forceinline__ u32x4 lane_gather(const u32x4 v, int idx4) { u32x4 r; r.x = (unsigned)__builtin_amdgcn_ds_bpermute(idx4, (int)v.x); r.y = (unsigned)__builtin_amdgcn_ds_bpermute(idx4, (int)v.y);
    r.z = (unsigned)__builtin_amdgcn_ds_bpermute(idx4, (int)v.z); r.w = (unsigned)__builtin_amdgcn_ds_bpermute(idx4, (int)v.w); return r; }
struct EpiStore {
    static constexpr int PERM = 2; int gelu_tiles; int skip; unsigned* vbound;
    __device__ __forceinline__ void operator()(const f32x4 (&acc)[2][2][4][2], const Unit& u, int wr, int wc, int fr, int fq, LAS unsigned char*, int) const {
        if (skip == 1) return;
        if (vbound && u.ldc == 4096) { float mx = 0.f;
#pragma unroll
            for (int ai = 0; ai < 2; ++ai)
#pragma unroll
                for (int bj = 0; bj < 2; ++bj)
#pragma unroll
                    for (int m = 0; m < 4; ++m)
#pragma unroll
                        for (int n = 0; n < 2; ++n) { const f32x4 v = acc[ai][bj][m][n]; mx = fmaxf(fmaxf(mx, fmaxf(fabsf(v[0]), fabsf(v[1]))), fmaxf(fabsf(v[2]), fabsf(v[3]))); }
            mx = wave_max(mx); if (fr == 0 && fq == 0) atomicMax(vbound + (u.pm >> 1) * 16 + u.pn, __builtin_bit_cast(unsigned, mx * 1.01f)); }
        const bool lo = fr < 8; const bool act = u.pn < gelu_tiles; const int lane = fq * 16 + fr;
        const int idx4 = 4 * ((lane & 3) * 16 + (lane >> 3) + 8 * ((lane >> 2) & 1));
        const int row0 = u.pm * BM + wr * 64 + (lane >> 3), col0 = u.pn * BM + wc * 64 + 8 * (lane & 7);
#pragma unroll
        for (int ai = 0; ai < 2; ++ai)
#pragma unroll
            for (int m = 0; m < 4; ++m) { u32x4 Pk[2];
#pragma unroll
                for (int bj = 0; bj < 2; ++bj) { f32x4 v0 = acc[ai][bj][m][0], v1 = acc[ai][bj][m][1];
                    if (act) { f32x2 a = gelu_pk((f32x2){v0[0], v0[1]}), b = gelu_pk((f32x2){v0[2], v0[3]}), c = gelu_pk((f32x2){v1[0], v1[1]}), d = gelu_pk((f32x2){v1[2], v1[3]});
                        v0 = (f32x4){a.x, a.y, b.x, b.y}; v1 = (f32x4){c.x, c.y, d.x, d.y}; }
                    Pk[bj].x = cvt_pk_bf16(v0[0], v0[1]); Pk[bj].y = cvt_pk_bf16(v0[2], v0[3]); Pk[bj].z = cvt_pk_bf16(v1[0], v1[1]); Pk[bj].w = cvt_pk_bf16(v1[2], v1[3]); }
                u32x4 S1, S2; xchg_pk(Pk[0], Pk[1], lo, S1, S2); S1 = lane_gather(S1, idx4); S2 = lane_gather(S2, idx4);
                bf16* rowp = u.O + (size_t)(row0 + ai * HALF + m * 16) * u.ldc + col0;
                if (skip == 4) { const int wv = wr * 4 + wc, t0 = (ai * 4 + m) * 2; bf16* q0 = u.O + (size_t)(u.pm * BM + 2 * (t0 * 8 + wv) + (lane >> 5)) * u.ldc + u.pn * BM + 8 * (lane & 31);
                    *(u32x4*)q0 = S1; *(u32x4*)(q0 + (size_t)16 * u.ldc) = S2; }
                else { *(u32x4*)rowp = S1; *(u32x4*)(rowp + (size_t)8 * u.ldc) = S2; } }
    }
};
struct EpiStoreI8 {
    static constexpr int PERM = 2; int gelu_tiles, mul_lo, mul_hi;
    __device__ __forceinline__ void operator()(const i32x4 (&acc)[2][2][4][2], const Unit& u, int wr, int wc, int fr, int fq, LAS unsigned char* lds, int slot) const {
        const bool lo = fr < 8; const bool act = u.pn < gelu_tiles; const int lane = fq * 16 + fr;
        const int idx4 = 4 * ((lane & 3) * 16 + (lane >> 3) + 8 * ((lane >> 2) & 1));
        const bool mul = u.pn >= mul_lo && u.pn < mul_hi;
        const int colbase = u.pn < mul_lo ? u.pn * BM : (mul ? mul_lo * BM + (u.pn - mul_lo) * HALF : mul_lo * BM + (mul_hi - mul_lo) * HALF + (u.pn - mul_hi) * BM);
        const LAS float* rsl = (const LAS float*)(lds + META_OFF + slot * META_SLOT + 1024); const LAS float* csl = (const LAS float*)(lds + META_OFF + slot * META_SLOT + 2048);
        f32x4 cv[2][2];
#pragma unroll
        for (int bj = 0; bj < 2; ++bj)
#pragma unroll
            for (int n = 0; n < 2; ++n) cv[bj][n] = *(const LAS f32x4*)(csl + wc * 64 + 32 * bj + 8 * fq + 4 * n);
        if (mul) {
            const int prow0 = u.pm * BM + wr * 64 + fr, pcol0 = colbase + wc * 32 + 8 * fq;
#pragma unroll
            for (int ai = 0; ai < 2; ++ai)
#pragma unroll
                for (int m = 0; m < 4; ++m) { const float rsv = rsl[ai * HALF + wr * 64 + m * 16 + fr]; float hv[8];
#pragma unroll
                    for (int k = 0; k < 8; ++k) hv[k] = ((float)acc[ai][0][m][k >> 2][k & 3] * (rsv * cv[0][k >> 2][k & 3])) * ((float)acc[ai][1][m][k >> 2][k & 3] * (rsv * cv[1][k >> 2][k & 3]));
                    u32x4 w; w.x = cvt_pk_bf16(hv[0], hv[1]); w.y = cvt_pk_bf16(hv[2], hv[3]); w.z = cvt_pk_bf16(hv[4], hv[5]); w.w = cvt_pk_bf16(hv[6], hv[7]);
                    *(u32x4*)(u.O + (size_t)(prow0 + ai * HALF + m * 16) * u.ldc + pcol0) = w; }
            return; }
        const int row0 = u.pm * BM + wr * 64 + (lane >> 3), col0 = colbase + wc * 64 + 8 * (lane & 7);
#pragma unroll
        for (int ai = 0; ai < 2; ++ai)
#pragma unroll
            for (int m = 0; m < 4; ++m) { u32x4 Pk[2]; const float rsv = rsl[ai * HALF + wr * 64 + m * 16 + fr];
#pragma unroll
                for (int bj = 0; bj < 2; ++bj) { f32x4 v0, v1;
#pragma unroll
                    for (int k = 0; k < 4; ++k) { v0[k] = (float)acc[ai][bj][m][0][k] * (rsv * cv[bj][0][k]); v1[k] = (float)acc[ai][bj][m][1][k] * (rsv * cv[bj][1][k]); }
                    if (act) { f32x2 a = gelu_pk((f32x2){v0[0], v0[1]}), b = gelu_pk((f32x2){v0[2], v0[3]}), c = gelu_pk((f32x2){v1[0], v1[1]}), d = gelu_pk((f32x2){v1[2], v1[3]});
                        v0 = (f32x4){a.x, a.y, b.x, b.y}; v1 = (f32x4){c.x, c.y, d.x, d.y}; }
                    Pk[bj].x = cvt_pk_bf16(v0[0], v0[1]); Pk[bj].y = cvt_pk_bf16(v0[2], v0[3]); Pk[bj].z = cvt_pk_bf16(v1[0], v1[1]); Pk[bj].w = cvt_pk_bf16(v1[2], v1[3]); }
                u32x4 S1, S2; xchg_pk(Pk[0], Pk[1], lo, S1, S2); S1 = lane_gather(S1, idx4); S2 = lane_gather(S2, idx4);
                bf16* rowp = u.O + (size_t)(row0 + ai * HALF + m * 16) * u.ldc + col0;
                *(u32x4*)rowp = S1; *(u32x4*)(rowp + (size_t)8 * u.ldc) = S2; }
    }
};
struct EpiResidI8 {
    static constexpr int PERM = 2; const bf16* R;
    __device__ __forceinline__ void operator()(const i32x4 (&acc)[2][2][4][2], const Unit& u, int wr, int wc, int fr, int fq, LAS unsigned char* lds, int slot) const {
        const bool lo = fr < 8; const int lane = fq * 16 + fr;
        const int idx4 = 4 * ((lane & 3) * 16 + (lane >> 3) + 8 * ((lane >> 2) & 1));
        const int row0 = u.pm * BM + wr * 64 + (lane >> 3), col0 = u.pn * BM + wc * 64 + 8 * (lane & 7);
        const LAS float* rsl = (const LAS float*)(lds + META_OFF + slot * META_SLOT + 1024); const LAS float* csl = (const LAS float*)(lds + META_OFF + slot * META_SLOT + 2048);
        f32x4 cv[2][2];
#pragma unroll
        for (int bj = 0; bj < 2; ++bj)
#pragma unroll
            for (int n = 0; n < 2; ++n) cv[bj][n] = *(const LAS f32x4*)(csl + wc * 64 + 32 * bj + 8 * fq + 4 * n);
#pragma unroll
        for (int ai = 0; ai < 2; ++ai) { u32x4 rr[4][2];
#pragma unroll
            for (int m = 0; m < 4; ++m) { const size_t off = (size_t)(row0 + ai * HALF + m * 16) * u.ldc + col0; rr[m][0] = *(const u32x4*)(R + off); rr[m][1] = *(const u32x4*)(R + off + (size_t)8 * u.ldc); }
#pragma unroll
            for (int m = 0; m < 4; ++m) { u32x4 Pk[2]; const float rsv = rsl[ai * HALF + wr * 64 + m * 16 + fr];
#pragma unroll
                for (int bj = 0; bj < 2; ++bj) { float v[8];
#pragma unroll
                    for (int k = 0; k < 8; ++k) v[k] = (float)acc[ai][bj][m][k >> 2][k & 3] * (rsv * cv[bj][k >> 2][k & 3]);
                    Pk[bj].x = cvt_pk_bf16(v[0], v[1]); Pk[bj].y = cvt_pk_bf16(v[2], v[3]); Pk[bj].z = cvt_pk_bf16(v[4], v[5]); Pk[bj].w = cvt_pk_bf16(v[6], v[7]); }
                u32x4 S1, S2; xchg_pk(Pk[0], Pk[1], lo, S1, S2); S1 = lane_gather(S1, idx4); S2 = lane_gather(S2, idx4);
                const u32x4 r1 = rr[m][0], r2 = rr[m][1]; u32x4 w1, w2;
                w1.x = cvt_pk_bf16(bflo(S1.x) + ALPHA * bflo(r1.x), bfhi(S1.x) + ALPHA * bfhi(r1.x)); w1.y = cvt_pk_bf16(bflo(S1.y) + ALPHA * bflo(r1.y), bfhi(S1.y) + ALPHA * bfhi(r1.y));
                w1.z = cvt_pk_bf16(bflo(S1.z) + ALPHA * bflo(r1.z), bfhi(S1.z) + ALPHA * bfhi(r1.z)); w1.w = cvt_pk_bf16(bflo(S1.w) + ALPHA * bflo(r1.w), bfhi(S1.w) + ALPHA * bfhi(r1.w));
                w2.x = cvt_pk_bf16(bflo(S2.x) + ALPHA * bflo(r2.x), bfhi(S2.x) + ALPHA * bfhi(r2.x)); w2.y = cvt_pk_bf16(bflo(S2.y) + ALPHA * bflo(r2.y), bfhi(S2.y) + ALPHA * bfhi(r2.y));
                w2.z = cvt_pk_bf16(bflo(S2.z) + ALPHA * bflo(r2.z), bfhi(S2.z) + ALPHA * bfhi(r2.z)); w2.w = cvt_pk_bf16(bflo(S2.w) + ALPHA * bflo(r2.w), bfhi(S2.w) + ALPHA * bfhi(r2.w));
                bf16* rowp = u.O + (size_t)(row0 + ai * HALF + m * 16) * u.ldc + col0;
                *(u32x4*)rowp = w1; *(u32x4*)(rowp + (size_t)8 * u.ldc) = w2; } }
    }
};
struct EpiResid {
    static constexpr int PERM = 2; const bf16* R;
    __device__ __forceinline__ void operator()(const f32x4 (&acc)[2][2][4][2], const Unit& u, int wr, int wc, int fr, int fq, LAS unsigned char*, int) const {
        const bool lo = fr < 8;
        const int row0 = u.pm * BM + wr * 64 + (fr & 7), col0 = u.pn * BM + wc * 64 + (lo ? 0 : 32) + 8 * fq;
        u32x4 rr[2][4][2];
#pragma unroll
        for (int ai = 0; ai < 2; ++ai)
#pragma unroll
            for (int m = 0; m < 4; ++m) { const size_t off = (size_t)(row0 + ai * HALF + m * 16) * u.ldc + col0; rr[ai][m][0] = *(const u32x4*)(R + off); rr[ai][m][1] = *(const u32x4*)(R + off + (size_t)8 * u.ldc); }
#pragma unroll
        for (int ai = 0; ai < 2; ++ai)
#pragma unroll
            for (int m = 0; m < 4; ++m) { const size_t off = (size_t)(row0 + ai * HALF + m * 16) * u.ldc + col0;
                float s1[8], s2[8];
#pragma unroll
                for (int k = 0; k < 8; ++k) { const float a = acc[ai][0][m][k >> 2][k & 3], b = acc[ai][1][m][k >> 2][k & 3]; const float y = ror8f(lo ? b : a); s1[k] = lo ? a : y; s2[k] = lo ? y : b; }
                const u32x4 r1 = rr[ai][m][0], r2 = rr[ai][m][1];
                u32x4 w1, w2;
                w1.x = cvt_pk_bf16(s1[0] + ALPHA * bflo(r1.x), s1[1] + ALPHA * bfhi(r1.x)); w1.y = cvt_pk_bf16(s1[2] + ALPHA * bflo(r1.y), s1[3] + ALPHA * bfhi(r1.y));
                w1.z = cvt_pk_bf16(s1[4] + ALPHA * bflo(r1.z), s1[5] + ALPHA * bfhi(r1.z)); w1.w = cvt_pk_bf16(s1[6] + ALPHA * bflo(r1.w), s1[7] + ALPHA * bfhi(r1.w));
                w2.x = cvt_pk_bf16(s2[0] + ALPHA * bflo(r2.x), s2[1] + ALPHA * bfhi(r2.x)); w2.y = cvt_pk_bf16(s2[2] + ALPHA * bflo(r2.y), s2[3] + ALPHA * bfhi(r2.y));
                w2.z = cvt_pk_bf16(s2[4] + ALPHA * bflo(r2.z), s2[5] + ALPHA * bfhi(r2.z)); w2.w = cvt_pk_bf16(s2[6] + ALPHA * bflo(r2.w), s2[7] + ALPHA * bfhi(r2.w));
                *(u32x4*)(u.O + off) = w1; *(u32x4*)(u.O + off + (size_t)8 * u.ldc) = w2; }
    }
};
__device__ __forceinline__ float silu_mul(float g, float uu) { return g * __builtin_amdgcn_rcpf(1.f + __builtin_amdgcn_exp2f(-1.44269504089f * g)) * uu; }
struct EpiSwiGLU {
    static constexpr int PERM = 1;
    __device__ __forceinline__ void operator()(const f32x4 (&acc)[2][2][4][2], const Unit& u, int wr, int wc, int fr, int fq, LAS unsigned char*, int) const {
        const int row0 = u.pm * BM + wr * 64 + fr, col0 = u.pn * HALF + wc * 32 + 8 * fq;
#pragma unroll
        for (int ai = 0; ai < 2; ++ai)
#pragma unroll
            for (int m = 0; m < 4; ++m) { const f32x4 g0 = acc[ai][0][m][0], g1 = acc[ai][0][m][1], u0 = acc[ai][1][m][0], u1 = acc[ai][1][m][1];
                u32x4 w; w.x = cvt_pk_bf16(silu_mul(g0[0], u0[0]), silu_mul(g0[1], u0[1])); w.y = cvt_pk_bf16(silu_mul(g0[2], u0[2]), silu_mul(g0[3], u0[3]));
                w.z = cvt_pk_bf16(silu_mul(g1[0], u1[0]), silu_mul(g1[1], u1[1])); w.w = cvt_pk_bf16(silu_mul(g1[2], u1[2]), silu_mul(g1[3], u1[3]));
                *(u32x4*)(u.O + (size_t)(row0 + ai * HALF + m * 16) * u.ldc + col0) = w; }
    }
};
__device__ __forceinline__ unsigned pk4_fp8(float a, float b, float c, float d) { int r = __builtin_amdgcn_cvt_pk_fp8_f32(a, b, 0, false); r = __builtin_amdgcn_cvt_pk_fp8_f32(c, d, r, true); return (unsigned)r; }
struct EpiSwiGLUI8 {
    static constexpr int PERM = 1;
    __device__ __forceinline__ void operator()(const i32x4 (&acc)[2][2][4][2], const Unit& u, int wr, int wc, int fr, int fq, LAS unsigned char* lds, int slot) const {
        const int row0 = u.pm * BM + wr * 64 + fr, col0 = u.pn * HALF + wc * 32 + 8 * fq;
        const LAS float* rsl = (const LAS float*)(lds + META_OFF + slot * META_SLOT + 1024); const LAS float* csl = (const LAS float*)(lds + META_OFF + slot * META_SLOT + 2048);
        f32x4 cg[2], cu[2];
#pragma unroll
        for (int n = 0; n < 2; ++n) { cg[n] = *(const LAS f32x4*)(csl + wc * 32 + 8 * fq + 4 * n); cu[n] = *(const LAS f32x4*)(csl + HALF + wc * 32 + 8 * fq + 4 * n) * H_SCALE; }
        unsigned char* HQ = (unsigned char*)u.O;
#pragma unroll
        for (int ai = 0; ai < 2; ++ai)
#pragma unroll
            for (int m = 0; m < 4; ++m) { const int r = ai * HALF + wr * 64 + m * 16 + fr; const float rsv = r < u.nvalid ? rsl[r] : 0.f; float hv[8];
                const f32x2 rs2 = (f32x2){rsv, rsv};
#pragma unroll
                for (int j = 0; j < 4; ++j) { const int k = 2 * j;
                    const f32x2 ag = (f32x2){(float)acc[ai][0][m][k >> 2][k & 3], (float)acc[ai][0][m][k >> 2][(k & 3) + 1]}, au = (f32x2){(float)acc[ai][1][m][k >> 2][k & 3], (float)acc[ai][1][m][k >> 2][(k & 3) + 1]};
                    const f32x2 tg = ag * (rs2 * (f32x2){cg[k >> 2][k & 3], cg[k >> 2][(k & 3) + 1]}), hu = au * (rs2 * (f32x2){cu[k >> 2][k & 3], cu[k >> 2][(k & 3) + 1]}), tn = tg * (-1.44269504089f);
                    f32x2 e; e.x = __builtin_amdgcn_exp2f(tn.x); e.y = __builtin_amdgcn_exp2f(tn.y);
                    const f32x2 d = e + 1.f; f32x2 rr; rr.x = __builtin_amdgcn_rcpf(d.x); rr.y = __builtin_amdgcn_rcpf(d.y);
                    const f32x2 hh = (tg * rr) * hu;
                    hv[k] = __builtin_amdgcn_fmed3f(hh.x, -448.f, 448.f); hv[k + 1] = __builtin_amdgcn_fmed3f(hh.y, -448.f, 448.f); }
                u32x2 w; w.x = pk4_fp8(hv[0], hv[1], hv[2], hv[3]); w.y = pk4_fp8(hv[4], hv[5], hv[6], hv[7]);
                *(u32x2*)(HQ + (size_t)(row0 + ai * HALF + m * 16) * 512 + col0) = w; }
    }
};
struct EpiScatter {
    static constexpr int PERM = 2;
    __device__ __forceinline__ void operator()(const f32x4 (&acc)[2][2][4][2], const Unit& u, int wr, int wc, int fr, int fq, LAS unsigned char* lds, int slot) const {
        const LAS unsigned* ent = (const LAS unsigned*)(lds + META_OFF + slot * META_SLOT); const bool lo = fr < 8; const int lane = fq * 16 + fr;
        const int idx4 = 4 * ((lane & 3) * 16 + (lane >> 3) + 8 * ((lane >> 2) & 1));
        const int col0 = u.pn * BM + wc * 64 + 8 * (lane & 7);
        unsigned char* Y8 = (unsigned char*)u.O;
#pragma unroll
        for (int ai = 0; ai < 2; ++ai)
#pragma unroll
            for (int m = 0; m < 4; ++m) { u32x2 Pk[2];
#pragma unroll
                for (int bj = 0; bj < 2; ++bj) { const f32x4 v0 = acc[ai][bj][m][0] * Y_SCALE, v1 = acc[ai][bj][m][1] * Y_SCALE; Pk[bj].x = pk4_fp8(v0[0], v0[1], v0[2], v0[3]); Pk[bj].y = pk4_fp8(v1[0], v1[1], v1[2], v1[3]); }
                u32x2 X, Yv, S1, S2; X.x = lo ? Pk[1].x : Pk[0].x; X.y = lo ? Pk[1].y : Pk[0].y; Yv.x = ror8u(X.x); Yv.y = ror8u(X.y);
                S1.x = lo ? Pk[0].x : Yv.x; S1.y = lo ? Pk[0].y : Yv.y; S2.x = lo ? Yv.x : Pk[1].x; S2.y = lo ? Yv.y : Pk[1].y;
                S1.x = (unsigned)__builtin_amdgcn_ds_bpermute(idx4, (int)S1.x); S1.y = (unsigned)__builtin_amdgcn_ds_bpermute(idx4, (int)S1.y); S2.x = (unsigned)__builtin_amdgcn_ds_bpermute(idx4, (int)S2.x); S2.y = (unsigned)__builtin_amdgcn_ds_bpermute(idx4, (int)S2.y);
                const int r1 = ai * HALF + wr * 64 + m * 16 + (lane >> 3), r2 = r1 + 8;
                if (r1 < u.nvalid) *(u32x2*)(Y8 + (size_t)ent[r1] * 1024 + col0) = S1;
                if (r2 < u.nvalid) *(u32x2*)(Y8 + (size_t)ent[r2] * 1024 + col0) = S2; }
    }
};

struct EpiStoreF8z {
    static constexpr int PERM = 2; int gelu_tiles, mul_lo, mul_hi;
    __device__ __forceinline__ void operator()(const i32x4 (&acc)[2][2][4][2], const Unit& u, int wr, int wc, int fr_in, int fq_in, LAS unsigned char* lds, int slot) const {
        (void)fr_in; (void)fq_in; int lane; asm volatile("v_mbcnt_lo_u32_b32 %0, -1, 0\n\tv_mbcnt_hi_u32_b32 %0, -1, %0" : "=v"(lane));
        const int fr = lane & 15, fq = lane >> 4;
        const bool lo = fr < 8; const bool act = u.pn < gelu_tiles;
        const int idx4 = 4 * ((lane & 3) * 16 + (lane >> 3) + 8 * ((lane >> 2) & 1));
        const bool mul = u.pn >= mul_lo && u.pn < mul_hi;
        const int colbase = u.pn < mul_lo ? u.pn * BM : (mul ? mul_lo * BM + (u.pn - mul_lo) * HALF : mul_lo * BM + (mul_hi - mul_lo) * HALF + (u.pn - mul_hi) * BM);
        const LAS float* rsl = (const LAS float*)(lds + META_OFF + slot * META_SLOT + 1024); const LAS float* csl = (const LAS float*)(lds + META_OFF + slot * META_SLOT + 2048);
        unsigned char* Z8 = (unsigned char*)u.O;
        f32x4 cv[2][2];
#pragma unroll
        for (int bj = 0; bj < 2; ++bj)
#pragma unroll
            for (int n = 0; n < 2; ++n) cv[bj][n] = *(const LAS f32x4*)(csl + wc * 64 + 32 * bj + 8 * fq + 4 * n);
        if (mul) {
            const int prow0 = u.pm * BM + wr * 64 + fr, pcol0 = colbase + wc * 32 + 8 * fq;
#pragma unroll
            for (int ai = 0; ai < 2; ++ai)
#pragma unroll
                for (int m = 0; m < 4; ++m) { const float rsv = rsl[ai * HALF + wr * 64 + m * 16 + fr], rsz = rsv * Z_SCALE; float hv[8];
#pragma unroll
                    for (int k = 0; k < 8; ++k) hv[k] = __builtin_amdgcn_fmed3f(((float)acc[ai][0][m][k >> 2][k & 3] * (rsz * cv[0][k >> 2][k & 3])) * ((float)acc[ai][1][m][k >> 2][k & 3] * (rsv * cv[1][k >> 2][k & 3])), -448.f, 448.f);
                    u32x2 w; w.x = pk4_fp8(hv[0], hv[1], hv[2], hv[3]); w.y = pk4_fp8(hv[4], hv[5], hv[6], hv[7]);
                    *(u32x2*)(Z8 + (size_t)(prow0 + ai * HALF + m * 16) * u.ldc + pcol0) = w; }
            return; }
        const int row0 = u.pm * BM + wr * 64 + (lane >> 3), col0 = colbase + wc * 64 + 8 * (lane & 7);
        const float zs = act ? 1.f : Z_SCALE, za = act ? Z_SCALE : 1.f;
#pragma unroll
        for (int ai = 0; ai < 2; ++ai)
#pragma unroll
            for (int m = 0; m < 4; ++m) { u32x2 Pk[2]; const float rsv = rsl[ai * HALF + wr * 64 + m * 16 + fr] * zs;
#pragma unroll
                for (int bj = 0; bj < 2; ++bj) { f32x4 v0, v1;
#pragma unroll
                    for (int k = 0; k < 4; ++k) { v0[k] = (float)acc[ai][bj][m][0][k] * (rsv * cv[bj][0][k]); v1[k] = (float)acc[ai][bj][m][1][k] * (rsv * cv[bj][1][k]); }
                    if (act) { f32x2 a = gelu_pk((f32x2){v0[0], v0[1]}) * za, b = gelu_pk((f32x2){v0[2], v0[3]}) * za, c = gelu_pk((f32x2){v1[0], v1[1]}) * za, d = gelu_pk((f32x2){v1[2], v1[3]}) * za;
                        v0 = (f32x4){a.x, a.y, b.x, b.y}; v1 = (f32x4){c.x, c.y, d.x, d.y}; }
                    Pk[bj].x = pk4_fp8(v0[0], v0[1], v0[2], v0[3]); Pk[bj].y = pk4_fp8(v1[0], v1[1], v1[2], v1[3]); }
                u32x2 X, Yv, S1, S2; X.x = lo ? Pk[1].x : Pk[0].x; X.y = lo ? Pk[1].y : Pk[0].y; Yv.x = ror8u(X.x); Yv.y = ror8u(X.y);
                S1.x = lo ? Pk[0].x : Yv.x; S1.y = lo ? Pk[0].y : Yv.y; S2.x = lo ? Yv.x : Pk[1].x; S2.y = lo ? Yv.y : Pk[1].y;
                S1.x = (unsigned)__builtin_amdgcn_ds_bpermute(idx4, (int)S1.x); S1.y = (unsigned)__builtin_amdgcn_ds_bpermute(idx4, (int)S1.y); S2.x = (unsigned)__builtin_amdgcn_ds_bpermute(idx4, (int)S2.x); S2.y = (unsigned)__builtin_amdgcn_ds_bpermute(idx4, (int)S2.y);
                unsigned char* rowp = Z8 + (size_t)(row0 + ai * HALF + m * 16) * u.ldc + col0;
                *(u32x2*)rowp = S1; *(u32x2*)(rowp + (size_t)8 * u.ldc) = S2; }
    }
};
struct EpiScatterF8 {
    static constexpr int PERM = 2;
    __device__ __forceinline__ void operator()(const f32x4 (&acc)[2][2][4][2], const Unit& u, int wr, int wc, int fr_in, int fq_in, LAS unsigned char* lds, int slot) const {
        (void)fr_in; (void)fq_in; int lane; asm volatile("v_mbcnt_lo_u32_b32 %0, -1, 0\n\tv_mbcnt_hi_u32_b32 %0, -1, %0" : "=v"(lane));
        const int fr = lane & 15, fq = lane >> 4;
        const LAS unsigned* ent = (const LAS unsigned*)(lds + META_OFF + slot * META_SLOT); const bool lo = fr < 8;
        const LAS float* csl = (const LAS float*)(lds + META_OFF + slot * META_SLOT + 2048);
        const int idx4 = 4 * ((lane & 3) * 16 + (lane >> 3) + 8 * ((lane >> 2) & 1));
        const int col0 = u.pn * BM + wc * 64 + 8 * (lane & 7);
        unsigned char* Y8 = (unsigned char*)u.O;
#pragma unroll
        for (int ai = 0; ai < 2; ++ai)
#pragma unroll
            for (int m = 0; m < 4; ++m) { u32x2 Pk[2];
#pragma unroll
                for (int bj = 0; bj < 2; ++bj) { const f32x4 c0 = *(const LAS f32x4*)(csl + wc * 64 + 32 * bj + 8 * fq), c1 = *(const LAS f32x4*)(csl + wc * 64 + 32 * bj + 8 * fq + 4);
                    const f32x4 v0 = acc[ai][bj][m][0] * (c0 * (Y_SCALE / H_SCALE)), v1 = acc[ai][bj][m][1] * (c1 * (Y_SCALE / H_SCALE)); Pk[bj].x = pk4_fp8(v0[0], v0[1], v0[2], v0[3]); Pk[bj].y = pk4_fp8(v1[0], v1[1], v1[2], v1[3]); }
                u32x2 X, Yv, S1, S2; X.x = lo ? Pk[1].x : Pk[0].x; X.y = lo ? Pk[1].y : Pk[0].y; Yv.x = ror8u(X.x); Yv.y = ror8u(X.y);
                S1.x = lo ? Pk[0].x : Yv.x; S1.y = lo ? Pk[0].y : Yv.y; S2.x = lo ? Yv.x : Pk[1].x; S2.y = lo ? Yv.y : Pk[1].y;
                S1.x = (unsigned)__builtin_amdgcn_ds_bpermute(idx4, (int)S1.x); S1.y = (unsigned)__builtin_amdgcn_ds_bpermute(idx4, (int)S1.y); S2.x = (unsigned)__builtin_amdgcn_ds_bpermute(idx4, (int)S2.x); S2.y = (unsigned)__builtin_amdgcn_ds_bpermute(idx4, (int)S2.y);
                const int r1 = ai * HALF + wr * 64 + m * 16 + (lane >> 3), r2 = r1 + 8;
                if (r1 < u.nvalid) *(u32x2*)(Y8 + (size_t)ent[r1] * 1024 + col0) = S1;
                if (r2 < u.nvalid) *(u32x2*)(Y8 + (size_t)ent[r2] * 1024 + col0) = S2; }
    }
};

template <class Epi, class Sched, bool GATHER, bool META, int KIND = 0, bool SCALES = false>
__device__ __forceinline__ void gemm_phase(LAS unsigned char* lds, const int PB, const Sched& S, const Epi& E) {
    int tid_ = threadIdx.x; asm volatile("" : "+v"(tid_));
    const int tid = tid_, wid = __builtin_amdgcn_readfirstlane(tid >> 6), lane = tid & 63, wr = wid >> 2, wc = wid & 3, fr = lane & 15, fq = lane >> 4;
    const int nt = PB / 128;
    unsigned voffA[2][2], nvoffA[2][2], voffB[2];
    const size_t hstep = (size_t)HALF * PB;
#pragma unroll
    for (int i = 0; i < 2; ++i) { int R, C; stage_rc(tid * 16 + i * 8192, R, C);
        voffA[0][i] = (unsigned)(R * PB + C * 2); voffA[1][i] = voffA[0][i] + (unsigned)hstep; nvoffA[0][i] = voffA[0][i]; nvoffA[1][i] = voffA[1][i];
        if (Epi::PERM == 2) { const int rb0 = 64 * (R >> 5) + perm32(R & 31); voffB[i] = (unsigned)(rb0 * PB + C * 2); }
        else { const int Rb = (R & ~31) + perm32(R & 31); voffB[i] = (unsigned)(Rb * PB + C * 2); } }
    const size_t bstep = Epi::PERM == 2 ? (size_t)32 * PB : hstep;
    const size_t kstep = 128;
    const unsigned ldsw = (unsigned)wid * 1024u, ldsu = (unsigned)(size_t)lds;
    const int aoff = lds_byte(wr * 64 + fr, fq * 8), boff = lds_byte(wc * 32 + fr, fq * 8);
#define PG8_SA(b, h) (((b) * 2 + (h)) * HTB)
#define PG8_SB(b, h) ((4 + (b) * 2 + (h)) * HTB)
#define PG8_STAGE(bufoff, gbase, voff) do { _Pragma("unroll") for (int _i = 0; _i < 2; ++_i) { unsigned _keep; \
        asm volatile("s_mov_b32 %0, m0\n\ts_mov_b32 m0, %3\n\tglobal_load_lds_dwordx4 %1, %2\n\ts_mov_b32 m0, %0" : "=&s"(_keep) : "v"((voff)[_i]), "s"((const char*)(gbase)), "s"(ldsu + (unsigned)(bufoff) + ldsw + _i * 8192u) : "memory"); } } while (0)
#define PG8_LDA(dst, b, h) do { _Pragma("unroll") for (int m = 0; m < 4; ++m) _Pragma("unroll") for (int k = 0; k < 2; ++k) dst[m][k] = *(const LAS bf16x8*)(lds + PG8_SA(b, h) + aoff + m * 2048 + k * 1024); } while (0)
#define PG8_LDB(dst, b, h) do { _Pragma("unroll") for (int n = 0; n < 2; ++n) _Pragma("unroll") for (int k = 0; k < 2; ++k) dst[n][k] = *(const LAS bf16x8*)(lds + PG8_SB(b, h) + boff + n * 2048 + k * 1024); } while (0)
#define PG8_MMA(ai, bj, At, Bt) do { __builtin_amdgcn_s_setprio(1); _Pragma("unroll") for (int m = 0; m < 4; ++m) _Pragma("unroll") for (int n = 0; n < 2; ++n) _Pragma("unroll") for (int k = 0; k < 2; ++k) \
        { if constexpr (KIND == 1) acc[ai][bj][m][n] = __builtin_bit_cast(ACC, __builtin_amdgcn_mfma_i32_16x16x64_i8(__builtin_bit_cast(i32x4, Bt[n][k]), __builtin_bit_cast(i32x4, At[m][k]), __builtin_bit_cast(i32x4, acc[ai][bj][m][n]), 0, 0, 0)); \
          else if constexpr (KIND == 2) { if (k == 0) { const i32x8 b8_ = __builtin_shufflevector(__builtin_bit_cast(i32x4, Bt[n][0]), __builtin_bit_cast(i32x4, Bt[n][1]), 0, 1, 2, 3, 4, 5, 6, 7), a8_ = __builtin_shufflevector(__builtin_bit_cast(i32x4, At[m][0]), __builtin_bit_cast(i32x4, At[m][1]), 0, 1, 2, 3, 4, 5, 6, 7); \
              asm volatile("v_mfma_f32_16x16x128_f8f6f4 %0, %1, %2, %0" : "+v"(acc[ai][bj][m][n]) : "v"(b8_), "v"(a8_)); } }     \
          else acc[ai][bj][m][n] = __builtin_bit_cast(ACC, __builtin_amdgcn_mfma_f32_16x16x32_bf16(Bt[n][k], At[m][k], __builtin_bit_cast(f32x4, acc[ai][bj][m][n]), 0, 0, 0)); } __builtin_amdgcn_s_setprio(0); } while (0)
#define PG8_WAIT_V(n) asm volatile("s_waitcnt vmcnt(" #n ")" ::: "memory")
#define PG8_WAIT_L(n) asm volatile("s_waitcnt lgkmcnt(" #n ")" ::: "memory")
#define PG8_BAR __builtin_amdgcn_s_barrier()
#define PG8_SCHED __builtin_amdgcn_sched_barrier(0)
#define PG8_GOFF(dst, slot, nv) do { const LAS unsigned* _e = (const LAS unsigned*)(lds + META_OFF + (slot) * META_SLOT); int _tq = tid; asm volatile("" : "+v"(_tq)); _Pragma("unroll") for (int _i = 0; _i < 2; ++_i) { int _R, _C; stage_rc(_tq * 16 + _i * 8192, _R, _C); \
        _Pragma("unroll") for (int _h = 0; _h < 2; ++_h) { const int _r = _h * HALF + _R; const unsigned _en = _e[_r]; const unsigned _row = (_r < (nv)) ? (_en >> 1) : 0u; dst[_h][_i] = _row * (unsigned)PB + (unsigned)_C * 2u; } } } while (0)
    Unit cur, nxt; int ui = 0;
    if (!S.next(0, cur)) return;
    typedef typename std::conditional<KIND == 1, i32x4, f32x4>::type ACC;
    ACC acc[2][2][4][2];
#pragma unroll
    for (int a = 0; a < 2; ++a)
#pragma unroll
        for (int b = 0; b < 2; ++b)
#pragma unroll
            for (int m = 0; m < 4; ++m)
#pragma unroll
                for (int n = 0; n < 2; ++n) acc[a][b][m][n] = (ACC){0, 0, 0, 0};
    bf16x8 At[4][2], B0[2][2], B1[2][2];
    const char* cA = cur.A; const char* cB = cur.B;
    int slot_cur = 0;
    if constexpr (META || SCALES) {
        if constexpr (META) { if (wid == 0) __builtin_amdgcn_global_load_lds(cur.meta + lane * 4, (LAS unsigned*)(lds + META_OFF), 16, 0, 0); }
        if constexpr (SCALES) { if (wid == 1) __builtin_amdgcn_global_load_lds((const unsigned*)cur.rs + lane * 4, (LAS unsigned*)(lds + META_OFF + 1024), 16, 0, 0);
                                if (wid == 2) __builtin_amdgcn_global_load_lds((const unsigned*)cur.cs + lane * 4, (LAS unsigned*)(lds + META_OFF + 2048), 16, 0, 0); }
        PG8_WAIT_V(0); __syncthreads();
        if constexpr (GATHER) PG8_GOFF(voffA, 0, cur.nvalid);
    }
    PG8_STAGE(PG8_SB(0, 0), cB, voffB); PG8_STAGE(PG8_SB(0, 1), cB + bstep, voffB); PG8_STAGE(PG8_SA(0, 0), cA, voffA[0]); PG8_STAGE(PG8_SA(0, 1), cA, voffA[1]);
    if (wr == 1) PG8_BAR;
    PG8_WAIT_V(2); PG8_BAR;
    PG8_STAGE(PG8_SB(1, 0), cB + kstep, voffB); PG8_STAGE(PG8_SA(1, 0), cA + kstep, voffA[0]); PG8_STAGE(PG8_SB(1, 1), cB + bstep + kstep, voffB);
    PG8_WAIT_V(6); PG8_BAR;
    for (;;) {
        const bool has_next = S.next(ui + 1, nxt);
        const char* nA = has_next ? nxt.A : cA; const char* nB = has_next ? nxt.B : cB;
        int slot_nxt = slot_cur + 1; if (slot_nxt == 3) slot_nxt = 0;
        if constexpr (META) { if (has_next && wid == 0) __builtin_amdgcn_global_load_lds(nxt.meta + lane * 4, (LAS unsigned*)(lds + META_OFF + slot_nxt * META_SLOT), 16, 0, 0); }
        if constexpr (SCALES) { if (has_next && wid == 1) __builtin_amdgcn_global_load_lds((const unsigned*)nxt.rs + lane * 4, (LAS unsigned*)(lds + META_OFF + slot_nxt * META_SLOT + 1024), 16, 0, 0);
                                if (has_next && wid == 2) __builtin_amdgcn_global_load_lds((const unsigned*)nxt.cs + lane * 4, (LAS unsigned*)(lds + META_OFF + slot_nxt * META_SLOT + 2048), 16, 0, 0); }
        for (int t = 0; t < nt; t += 2) {
            const bool last = (t == nt - 2);
            const char* a1 = cA + (size_t)(t + 1) * kstep;
            const char* a2 = last ? nA : cA + (size_t)(t + 2) * kstep; const char* b2 = last ? nB : cB + (size_t)(t + 2) * kstep;
            const char* a3 = a2 + kstep; const char* b3 = b2 + kstep;
            unsigned o2[2][2];
            if constexpr (GATHER) { if (last && has_next) PG8_GOFF(nvoffA, slot_nxt, nxt.nvalid); }
#pragma unroll
            for (int h = 0; h < 2; ++h)
#pragma unroll
                for (int i = 0; i < 2; ++i) o2[h][i] = (GATHER && last && has_next) ? nvoffA[h][i] : voffA[h][i];
            PG8_LDB(B0, 0, 0); PG8_LDB(B1, 0, 1); PG8_SCHED; PG8_LDA(At, 0, 0); PG8_STAGE(PG8_SA(1, 1), a1, voffA[1]);
            PG8_WAIT_V(8); PG8_WAIT_L(0); PG8_BAR; PG8_MMA(0, 0, At, B0); PG8_MMA(0, 1, At, B1); PG8_BAR; PG8_SCHED;
            PG8_LDA(At, 0, 1); PG8_STAGE(PG8_SB(0, 0), b2, voffB); PG8_STAGE(PG8_SB(0, 1), b2 + bstep, voffB); PG8_STAGE(PG8_SA(0, 0), a2, o2[0]);
            PG8_WAIT_V(8); PG8_WAIT_L(0); PG8_BAR; PG8_MMA(1, 0, At, B0); PG8_MMA(1, 1, At, B1); PG8_BAR; PG8_SCHED;
            PG8_LDB(B0, 1, 0); PG8_LDB(B1, 1, 1); PG8_SCHED; PG8_LDA(At, 1, 0); PG8_STAGE(PG8_SA(0, 1), a2, o2[1]);
            PG8_WAIT_V(8); PG8_WAIT_L(0); PG8_BAR; PG8_MMA(0, 0, At, B0); PG8_MMA(0, 1, At, B1); PG8_BAR; PG8_SCHED;
            PG8_LDA(At, 1, 1); PG8_STAGE(PG8_SB(1, 0), b3, voffB); PG8_STAGE(PG8_SB(1, 1), b3 + bstep, voffB); PG8_STAGE(PG8_SA(1, 0), a3, o2[0]);
            PG8_WAIT_V(8); PG8_WAIT_L(0); PG8_BAR; PG8_MMA(1, 0, At, B0); PG8_MMA(1, 1, At, B1); PG8_BAR; PG8_SCHED;
        }
        if (wr == 0) PG8_BAR;
        if constexpr (KIND == 2) asm volatile("s_nop 7\n\ts_nop 7\n\ts_nop 3" ::: "memory");
        E(acc, cur, wr, wc, fr, fq, lds, slot_cur);
        if (!has_next) break;
#pragma unroll
        for (int a = 0; a < 2; ++a)
#pragma unroll
            for (int b = 0; b < 2; ++b)
#pragma unroll
                for (int m = 0; m < 4; ++m)
#pragma unroll
                    for (int n = 0; n < 2; ++n) acc[a][b][m][n] = (ACC){0, 0, 0, 0};
        cur = nxt; cA = nA; cB = nB; ++ui; slot_cur = slot_nxt;
        if constexpr (GATHER) {
#pragma unroll
            for (int h = 0; h < 2; ++h)
#pragma unroll
                for (int i = 0; i < 2; ++i) voffA[h][i] = nvoffA[h][i]; }
        if (wr == 1) PG8_BAR;
    }
    PG8_WAIT_V(0);
    PG8_BAR;
#undef PG8_SA
#undef PG8_SB
#undef PG8_STAGE
#undef PG8_LDA
#undef PG8_LDB
#undef PG8_MMA
#undef PG8_WAIT_V
#undef PG8_WAIT_L
#undef PG8_BAR
#undef PG8_SCHED
#undef PG8_GOFF
}
}

#define XB_TMO      128
#define XB_XCNT(j)  (256  + 64 * (j))
#define XB_XSUB(j)  (1280 + 64 * (j))
#define XB_XGEN(j)  (2304 + 64 * (j))
#define XB_TOP      3328
#define XB_TOPGEN   3392
#define XCD_BAR_WORDS 3456
#define XB_SPIN_CAP (1u << 22)
__device__ __forceinline__ unsigned xb_ld(unsigned* p)              { return __hip_atomic_load(p, __ATOMIC_RELAXED, __HIP_MEMORY_SCOPE_AGENT); }
__device__ __forceinline__ unsigned xb_add(unsigned* p, unsigned v) { return __hip_atomic_fetch_add(p, v, __ATOMIC_RELAXED, __HIP_MEMORY_SCOPE_AGENT); }
__device__ __forceinline__ unsigned xb_xcc_id() { return (unsigned)__builtin_amdgcn_s_getreg((3 << 11) | 20) & 0xFu; }
#define XB_SPIN(cond, bar) do { unsigned _sp = 0; while (cond) { __builtin_amdgcn_s_sleep(1); \
    if ((++_sp & 255u) == 0u) { if (xb_ld(&(bar)[XB_TMO])) break; if (_sp > XB_SPIN_CAP) { atomicAdd(&(bar)[XB_TMO], 1u); break; } } } } while (0)
struct XcdBarrier { unsigned* bar; unsigned x; volatile LAS unsigned* st; };
__device__ __forceinline__ XcdBarrier xcd_barrier_post(unsigned* bar, volatile LAS unsigned* st) {
    XcdBarrier b; b.bar = bar; b.x = xb_xcc_id(); b.st = st;
    if (threadIdx.x == 0) (void)xb_add(&bar[XB_XCNT(b.x)], 1u);
    return b;
}
__device__ __forceinline__ void xcd_barrier_complete(unsigned* bar, unsigned x, unsigned& nloc, unsigned& nx) {
    const unsigned G = gridDim.x * gridDim.y * gridDim.z;
    unsigned sum, cnt, mine, sp = 0u;
    for (;;) {
        sum = 0u; cnt = 0u; mine = 0u;
#pragma unroll
        for (unsigned j = 0; j < 16; ++j) { const unsigned c = xb_ld(&bar[XB_XCNT(j)]); sum += c; cnt += (c > 0u) ? 1u : 0u; mine = (j == x) ? c : mine; }
        if (sum == G) break;
        __builtin_amdgcn_s_sleep(1);
        if ((++sp & 255u) == 0u) { if (xb_ld(&bar[XB_TMO])) break; if (sp > XB_SPIN_CAP) { atomicAdd(&bar[XB_TMO], 1u); break; } }
    }
    nloc = mine > 0u ? mine : 1u; nx = cnt > 0u ? cnt : 1u;
}
__device__ __forceinline__ void xcd_barrier(const XcdBarrier& b) {
    asm volatile("s_waitcnt vmcnt(0)" ::: "memory");
    __syncthreads();
    if (threadIdx.x == 0) {
        unsigned* bar = b.bar;
        __builtin_amdgcn_s_waitcnt(0);
        unsigned nloc = b.st[0], nx = b.st[1];
        if (nloc == 0u) { xcd_barrier_complete(bar, b.x, nloc, nx); b.st[0] = nloc; b.st[1] = nx; }
        const unsigned old = xb_add(&bar[XB_XSUB(b.x)], 1u);
        const unsigned gen = old / nloc;
        if (old + 1u == (gen + 1u) * nloc) {
            __builtin_amdgcn_fence(__ATOMIC_RELEASE, "agent");
            asm volatile("s_waitcnt vmcnt(0)" ::: "memory");
            const unsigned og = xb_add(&bar[XB_TOP], 1u);
            const unsigned tg = og / nx;
            if (og + 1u == (tg + 1u) * nx) xb_add(&bar[XB_TOPGEN], 1u);
            else XB_SPIN(xb_ld(&bar[XB_TOPGEN]) == tg, bar);
            __builtin_amdgcn_fence(__ATOMIC_ACQUIRE, "agent");
            xb_add(&bar[XB_XGEN(b.x)], 1u);
            asm volatile("s_waitcnt vmcnt(0)" ::: "memory");
        } else {
            XB_SPIN(xb_ld(&bar[XB_XGEN(b.x)]) == gen, bar);
            __builtin_amdgcn_fence(__ATOMIC_ACQUIRE, "agent");
            asm volatile("s_waitcnt vmcnt(0)" ::: "memory");
        }
    }
    __syncthreads();
}
constexpr int CW_BAR = 4096;

typedef short s16x4 __attribute__((ext_vector_type(4)));
constexpr int VN_PITCH = 1056;
__device__ __forceinline__ s16x4 ds_tr16(LAS unsigned char* p) { return __builtin_bit_cast(s16x4, __builtin_amdgcn_ds_read_tr16_b64_v4i16((LAS s16x4*)p)); }
__device__ __forceinline__ bf16x8 cat8(s16x4 a, s16x4 b) { bf16x8 r; r[0] = a[0]; r[1] = a[1]; r[2] = a[2]; r[3] = a[3]; r[4] = b[0]; r[5] = b[1]; r[6] = b[2]; r[7] = b[3]; return r; }
__device__ __forceinline__ void sgu_unit(const Ptrs& P, LAS unsigned char* lds, unsigned char* ws, int t0, int lane, int wave, int l15, int g, float vb) {
    const unsigned char* Z = (const unsigned char*)(ws + WS_Z); signed char* CATQ = (signed char*)(ws + WS_CAT);
    {
        LAS float* gl = (LAS float*)(lds + 128 * VN_PITCH); LAS float* bl = gl + 512;
        if (threadIdx.x < 128) { ((LAS f32x4*)gl)[threadIdx.x] = ((const f32x4*)P.sgu_ln_g)[threadIdx.x]; ((LAS f32x4*)bl)[threadIdx.x] = ((const f32x4*)P.sgu_ln_b)[threadIdx.x]; }
        const int j = wave * 16 + l15; const unsigned char* vrow = Z + ((size_t)t0 + j) * 1536 + 512 + 128 * g;
        u32x2 raw[16];
#pragma unroll
        for (int i = 0; i < 16; ++i) raw[i] = *(const u32x2*)(vrow + 8 * i);
        float s1 = 0.f, s2 = 0.f;
#pragma unroll
        for (int i = 0; i < 16; ++i) { float v[8]; unpack_fp8x8(raw[i], v);
#pragma unroll
            for (int q = 0; q < 8; ++q) { s1 += v[q]; s2 += v[q] * v[q]; } }
        s1 += __shfl_xor(s1, 16); s1 += __shfl_xor(s1, 32); s2 += __shfl_xor(s2, 16); s2 += __shfl_xor(s2, 32);
        const float mean = s1 * (1.f / 512.f), rstd = rsqrtf(fmaxf(s2 * (1.f / 512.f) - mean * mean, 0.f) + LN_EPS * (Z_SCALE * Z_SCALE));
        __syncthreads();
#pragma unroll
        for (int i = 0; i < 16; ++i) { u32x2 rk = raw[i]; asm volatile("" : "+v"(rk)); float v[8]; unpack_fp8x8(rk, v);
            const f32x4 g0 = *(const LAS f32x4*)(gl + 128 * g + 8 * i), g1 = *(const LAS f32x4*)(gl + 128 * g + 8 * i + 4), b0 = *(const LAS f32x4*)(bl + 128 * g + 8 * i), b1 = *(const LAS f32x4*)(bl + 128 * g + 8 * i + 4);
#pragma unroll
            for (int q = 0; q < 8; ++q) { const float gq = q < 4 ? g0[q & 3] : g1[q & 3], bq = q < 4 ? b0[q & 3] : b1[q & 3]; const float scl = rstd * gq; v[q] = v[q] * scl + (bq - mean * scl); }
            *(LAS u32x4*)(lds + j * VN_PITCH + (128 * g + 8 * i) * 2) = pack8(v); }
    }
    __syncthreads();
    {
        const int h = wave >> 1, dbase = h * 128 + (wave & 1) * 64, q = l15 >> 2, pp = l15 & 3;
        bf16x8 af[4][4];
#pragma unroll
        for (int mt = 0; mt < 4; ++mt)
#pragma unroll
            for (int ks = 0; ks < 4; ++ks) { LAS unsigned char* a0 = lds + (32 * ks + 4 * g + q) * VN_PITCH + (dbase + 16 * mt + 4 * pp) * 2; af[mt][ks] = cat8(ds_tr16(a0), ds_tr16(a0 + 16 * VN_PITCH)); }
        const bf16* SW = (const bf16*)(ws + WS_WSGU) + (size_t)(h * 128 + l15) * 128 + 8 * g;
        asm volatile("s_waitcnt lgkmcnt(0)" ::: "memory"); __syncthreads();
#pragma unroll
        for (int it = 0; it < 8; ++it) { const int nks = it < 4 ? 2 : 4;
            const int i = 16 * it + l15; const size_t tok = (size_t)t0 + i;
            bf16x8 bfr[4]; unsigned uw[4];
#pragma unroll
            for (int ks = 0; ks < 4; ++ks) if (ks < nks) bfr[ks] = *(const bf16x8*)(SW + (size_t)(16 * it) * 128 + 32 * ks);
#pragma unroll
            for (int mt = 0; mt < 4; ++mt) uw[mt] = *(const unsigned*)(Z + tok * 1536 + dbase + 16 * mt + 4 * g);
            const float bias = P.sgu_b[h * 128 + i] * (1.f / Z_SCALE);
            f32x4 acc[4];
#pragma unroll
            for (int mt = 0; mt < 4; ++mt) acc[mt] = (f32x4){0.f, 0.f, 0.f, 0.f};
#pragma unroll
            for (int ks = 0; ks < 4; ++ks) if (ks < nks) {
#pragma unroll
                for (int mt = 0; mt < 4; ++mt) acc[mt] = __builtin_amdgcn_mfma_f32_16x16x32_bf16(af[mt][ks], bfr[ks], acc[mt], 0, 0, 0); }
#pragma unroll
            for (int mt = 0; mt < 4; ++mt) { const int d = dbase + 16 * mt + 4 * g;
                const auto ul = __builtin_amdgcn_cvt_pk_f32_fp8((int)uw[mt], false), uh = __builtin_amdgcn_cvt_pk_f32_fp8((int)uw[mt], true);
                u32x2 o; o.x = pg8::cvt_pk_bf16(ul[0] * (acc[mt][0] + bias), ul[1] * (acc[mt][1] + bias)); o.y = pg8::cvt_pk_bf16(uh[0] * (acc[mt][2] + bias), uh[1] * (acc[mt][3] + bias));
                *(LAS u32x2*)(lds + i * VN_PITCH + d * 2) = o; } }
    }
    __syncthreads();
    {
        LAS float* rowsc = (LAS float*)(lds + ROWSC_OFF);
#pragma unroll 4
        for (int rr = 0; rr < 16; ++rr) { const int i = wave * 16 + rr; float v[8]; unpack8(*(const LAS u32x4*)(lds + i * VN_PITCH + lane * 16), v);
            float mx = 0.f;
#pragma unroll
            for (int q = 0; q < 8; ++q) mx = fmaxf(mx, fabsf(v[q]));
            mx = fmaxf(wave_max(mx), vb); const float scale = mx > 0.f ? mx * (1.f / 127.f) : 1.f, inv = 1.f / scale;
            u32x2 qv; qv.x = pack4q(v[0] * inv, v[1] * inv, v[2] * inv, v[3] * inv); qv.y = pack4q(v[4] * inv, v[5] * inv, v[6] * inv, v[7] * inv);
            *(u32x2*)(CATQ + ((size_t)t0 + i) * D + lane * 8) = qv;
            if (lane == 0) { ((float*)(ws + WS_CSCALE))[t0 + i] = scale; rowsc[(t0 + i) & 255] = scale; } }
    }
}
__device__ __forceinline__ void mixer_pair(const Ptrs& P, LAS unsigned char* lds, int pair, int layer) {
    int tid_ = threadIdx.x; asm volatile("" : "+v"(tid_));
    const int tid = tid_, lane = tid & 63, wave = __builtin_amdgcn_readfirstlane(tid >> 6), l15 = lane & 15, g = lane >> 4;
    unsigned char* ws = fresh(P.ws); const unsigned char* Z = (const unsigned char*)(ws + WS_Z); signed char* CATQ = (signed char*)(ws + WS_CAT);
    const int t0 = pair * 256, b = t0 / SEQ; const int ldz = 1536, qoff = 1024;
    const float vb = __builtin_bit_cast(float, __hip_atomic_load((const unsigned*)(ws + WS_CTL) + CW_VBOUND + layer * 16 + b, __ATOMIC_RELAXED, __HIP_MEMORY_SCOPE_AGENT));
    LAS float* rowsc = (LAS float*)(lds + ROWSC_OFF);
#ifndef REP_SGU
#define REP_SGU 1
#endif
#ifndef REP_CONV
#define REP_CONV 1
#endif
#ifndef REP_ATT
#define REP_ATT 1
#endif
    if (layer == 0) {
#pragma unroll 1
        for (int rep = 0; rep < freshi(REP_SGU); ++rep) {
        __syncthreads();
        sgu_unit(P, lds, ws, t0, lane, wave, l15, g, vb);
        __syncthreads();
        sgu_unit(P, lds, ws, t0 + 128, lane, wave, l15, g, vb); }
    } else {
#pragma unroll 1
        for (int rep = 0; rep < freshi(REP_CONV); ++rep) { conv_unit(P, lds, 2 * pair, vb); conv_unit(P, lds, 2 * pair + 1, vb); } }
    int kbase[4], vb0[4], vb1[4];
#pragma unroll
    for (int j = 0; j < 4; ++j) { kbase[j] = l15 * 256 + (((4 * j + g) ^ l15) << 4); vb0[j] = 65536 + l15 * 512 + (g & 1) * 8 + (((4 * j + (g >> 1)) ^ l15) << 4); vb1[j] = 65536 + l15 * 512 + (g & 1) * 8 + (((4 * j + (g >> 1) + 2) ^ l15) << 4); }
    const char* KM = (const char*)(ws + WS_KMAT) + (size_t)(b * 256) * 2048 + (size_t)(layer * 512) * 2;
    const char* VT = (const char*)(ws + WS_VT) + (size_t)(layer * 512) * 8192 + (size_t)(b * 256) * 2;
    const unsigned ldsu = (unsigned)(size_t)lds;
#define ATT_DMA1(voff, gbase, ldsoff) do { unsigned keep_; asm volatile("s_mov_b32 %0, m0\n\ts_mov_b32 m0, %3\n\tglobal_load_lds_dwordx4 %1, %2\n\ts_mov_b32 m0, %0" : "=&s"(keep_) : "v"(voff), "s"(gbase), "s"(ldsu + (unsigned)(ldsoff)) : "memory"); } while (0)
#define ATT_DMA_K(h_) do { int ln_ = lane; asm volatile("" : "+v"(ln_)); const char* gb_ = KM + (h_) * 256; _Pragma("unroll") for (int ii = 0; ii < 8; ++ii) { const int I = wave * 8 + ii; const int row = 4 * I + (ln_ >> 4), c16 = (ln_ & 15) ^ (row & 15); \
        ATT_DMA1((unsigned)(row * 2048 + c16 * 16), gb_, I * 1024); } } while (0)
#define ATT_DMA_V(h_) do { int ln_ = lane; asm volatile("" : "+v"(ln_)); const char* gb_ = VT + (size_t)((h_) * 128) * 8192; _Pragma("unroll") for (int ii = 0; ii < 8; ++ii) { const int I = wave * 8 + ii; const int row = 2 * I + (ln_ >> 5), c32 = (ln_ & 31) ^ (row & 15); \
        ATT_DMA1((unsigned)(row * 8192 + c32 * 16), gb_, 65536 + I * 1024); } } while (0)
#define ATT_LDQ(h_) do { _Pragma("unroll") for (int su = 0; su < 2; ++su) _Pragma("unroll") for (int ks = 0; ks < 4; ++ks) qr[su][ks] = *(const u32x2*)(Z + ((size_t)t0 + su * 128 + wave * 16 + l15) * ldz + qoff + (h_) * 128 + 32 * ks + 8 * g); } while (0)
    const int nheads = NH * freshi(REP_ATT);
    u32x2 qr[2][4];
    __syncthreads();
#define ATT_QF_USE() asm volatile("" : "+v"(qr[0][0]), "+v"(qr[0][1]), "+v"(qr[0][2]), "+v"(qr[0][3]), "+v"(qr[1][0]), "+v"(qr[1][1]), "+v"(qr[1][2]), "+v"(qr[1][3]))
    ATT_DMA_K(0); ATT_LDQ(0); ATT_QF_USE(); ATT_DMA_V(0);
#pragma unroll 1
    for (int hh = 0; hh < nheads; ++hh) { const int h = hh & 3, hn = (hh + 1) & 3; const bool more = hh + 1 < nheads;
        if (hh == 0) asm volatile("s_waitcnt vmcnt(16)" ::: "memory"); else asm volatile("s_waitcnt vmcnt(32)" ::: "memory");
        __builtin_amdgcn_s_barrier();
        __builtin_amdgcn_sched_barrier(0);
        bf16x8 qf[2][4];
#pragma unroll
        for (int su = 0; su < 2; ++su)
#pragma unroll
            for (int ks = 0; ks < 4; ++ks) { float f[8]; unpack_fp8x8(qr[su][ks], f); u32x4 w; w.x = pg8::cvt_pk_bf16(f[0], f[1]); w.y = pg8::cvt_pk_bf16(f[2], f[3]); w.z = pg8::cvt_pk_bf16(f[4], f[5]); w.w = pg8::cvt_pk_bf16(f[6], f[7]); qf[su][ks] = __builtin_bit_cast(bf16x8, w); }
        f32x4 S[2][16];
        {
            bf16x8 kf[2][4];
#pragma unroll
            for (int q = 0; q < 4; ++q) kf[0][q] = *(const LAS bf16x8*)(lds + kbase[q]);
#pragma unroll
            for (int kt = 0; kt < 16; ++kt) {
                if (kt < 15) {
#pragma unroll
                    for (int q = 0; q < 4; ++q) kf[(kt + 1) & 1][q] = *(const LAS bf16x8*)(lds + kbase[q] + 4096 * (kt + 1)); }
                __builtin_amdgcn_sched_barrier(0);
#pragma unroll
                for (int ks = 0; ks < 4; ++ks)
#pragma unroll
                    for (int su = 0; su < 2; ++su) S[su][kt] = __builtin_amdgcn_mfma_f32_16x16x32_bf16(kf[kt & 1][ks], qf[su][ks], ks == 0 ? (f32x4){0.f, 0.f, 0.f, 0.f} : S[su][kt], 0, 0, 0);
                __builtin_amdgcn_sched_barrier(0);
            }
        }
        asm volatile("s_waitcnt lgkmcnt(0)" ::: "memory");
        __builtin_amdgcn_s_barrier();
        __builtin_amdgcn_sched_barrier(0);
        if (more) ATT_DMA_K(hn);
        float inv[2];
        bf16x8 pf[2][8];
#pragma unroll
        for (int su = 0; su < 2; ++su) {
            float mx = -3.0e38f;
#pragma unroll
            for (int kt = 0; kt < 16; ++kt) mx = fmaxf(fmaxf(mx, fmaxf(S[su][kt][0], S[su][kt][1])), fmaxf(S[su][kt][2], S[su][kt][3]));
            mx = fmaxf(mx, __shfl_xor(mx, 16)); mx = fmaxf(mx, __shfl_xor(mx, 32));
            const float sc = 0.08838834764831845f * 1.4426950408889634f / Z_SCALE; const float mxs = mx * sc; float sum = 0.f;
#pragma unroll
            for (int kt = 0; kt < 16; ++kt)
#pragma unroll
                for (int r = 0; r < 4; ++r) { const float pv = __builtin_amdgcn_exp2f(S[su][kt][r] * sc - mxs); S[su][kt][r] = pv; sum += pv; }
            sum += __shfl_xor(sum, 16); sum += __shfl_xor(sum, 32);
            inv[su] = 1.f / (sum * rowsc[su * 128 + wave * 16 + l15]);
#pragma unroll
            for (int sp = 0; sp < 8; ++sp) { u32x4 w; w.x = pg8::cvt_pk_bf16(S[su][2 * sp][0], S[su][2 * sp][1]); w.y = pg8::cvt_pk_bf16(S[su][2 * sp][2], S[su][2 * sp][3]); w.z = pg8::cvt_pk_bf16(S[su][2 * sp + 1][0], S[su][2 * sp + 1][1]); w.w = pg8::cvt_pk_bf16(S[su][2 * sp + 1][2], S[su][2 * sp + 1][3]); pf[su][sp] = __builtin_bit_cast(bf16x8, w); }
        }
        if (more) ATT_LDQ(hn);
        if (more) asm volatile("s_waitcnt vmcnt(16)" ::: "memory"); else asm volatile("s_waitcnt vmcnt(0)" ::: "memory");
        __builtin_amdgcn_s_barrier();
        __builtin_amdgcn_sched_barrier(0);
        {
            s16x4 vf[2][8];
#pragma unroll
            for (int q = 0; q < 4; ++q) { vf[0][2 * q] = *(const LAS s16x4*)(lds + vb0[q]); vf[0][2 * q + 1] = *(const LAS s16x4*)(lds + vb1[q]); }
            f32x4 O[2];
#pragma unroll
            for (int bt = 0; bt < 16; ++bt) { const int dt = bt >> 1, hf = bt & 1;
                if (bt < 15) { const int nd = (bt + 1) >> 1, nh = (bt + 1) & 1;
#pragma unroll
                    for (int q = 0; q < 4; ++q) { vf[(bt + 1) & 1][2 * q] = *(const LAS s16x4*)(lds + vb0[q] + 8192 * nd + 256 * nh); vf[(bt + 1) & 1][2 * q + 1] = *(const LAS s16x4*)(lds + vb1[q] + 8192 * nd + 256 * nh); } }
                __builtin_amdgcn_sched_barrier(0);
#pragma unroll
                for (int q = 0; q < 4; ++q)
#pragma unroll
                    for (int su = 0; su < 2; ++su) O[su] = __builtin_amdgcn_mfma_f32_16x16x32_bf16(cat8(vf[bt & 1][2 * q], vf[bt & 1][2 * q + 1]), pf[su][4 * hf + q], (hf == 0 && q == 0) ? (f32x4){0.f, 0.f, 0.f, 0.f} : O[su], 0, 0, 0);
                if (hf == 1) {
#pragma unroll
                    for (int su = 0; su < 2; ++su) { const size_t tokrow = (size_t)t0 + su * 128 + wave * 16 + l15;
                        *(unsigned*)(CATQ + tokrow * D + 512 + h * 128 + 16 * dt + 4 * g) = pack4q(O[su][0] * inv[su], O[su][1] * inv[su], O[su][2] * inv[su], O[su][3] * inv[su]); } }
                __builtin_amdgcn_sched_barrier(0);
            }
        }
        asm volatile("s_waitcnt lgkmcnt(0)" ::: "memory");
        __builtin_amdgcn_s_barrier();
        __builtin_amdgcn_sched_barrier(0);
        ATT_QF_USE();
        __builtin_amdgcn_sched_barrier(0);
        if (more) ATT_DMA_V(hn);
    }
#undef ATT_DMA1
#undef ATT_DMA_K
#undef ATT_DMA_V
#undef ATT_LDQ
#undef ATT_QF_USE
}

constexpr int LDS_BYTES = 155648;
struct Args { Ptrs P; int ph_lo, ph_hi; };
__global__ void __launch_bounds__(512, 2) mk_fwd(Args args) {
    extern __shared__ __attribute__((aligned(16))) unsigned char lds_raw[];
    LAS unsigned char* lds = (LAS unsigned char*)lds_raw;
    const Ptrs& P = args.P;
    const int lo = args.ph_lo, hi = args.ph_hi;
#define G freshi((int)gridDim.x)
#define c freshi((int)blockIdx.x)
    volatile LAS unsigned* MISC = (volatile LAS unsigned*)(lds + LDS_BYTES - 64);
    if (threadIdx.x < 16) MISC[threadIdx.x] = 0u;
    __syncthreads();
    if (hi - lo > 1) (void)xcd_barrier_post((unsigned*)(args.P.ws + WS_CTL) + CW_BAR, MISC);
#define SEAM(k) do { if (IN(k) && (k) + 1 < hi) { XcdBarrier bar_; bar_.bar = (unsigned*)(args.P.ws + WS_CTL) + CW_BAR; bar_.x = xb_xcc_id(); bar_.st = (volatile LAS unsigned*)(lds + LDS_BYTES - 64); xcd_barrier(bar_); } } while (0)
#define LSEAM(k) do { if (IN(k) && (k) + 1 < hi) { asm volatile("s_waitcnt vmcnt(0)" ::: "memory"); __syncthreads(); } } while (0)
#ifndef PHMASK
#define PHMASK 0xffff
#endif
#define IN(k) (((PHMASK >> ((k) < 2 ? (k) : 2 + ((k) - 2) % 7)) & 1) && lo <= (k) && (k) < hi)
#ifndef REPMASK
#define REPMASK 0
#endif
#ifndef DUMMY_INPROJ
#define DUMMY_INPROJ 0
#endif
#ifndef SKIP_EPI
#define SKIP_EPI 0
#endif
#define KIDX(k) ((k) < 2 ? (k) : 2 + ((k) - 2) % 7)
#define GBAR() do { XcdBarrier bar_; bar_.bar = (unsigned*)(args.P.ws + WS_CTL) + CW_BAR; bar_.x = xb_xcc_id(); bar_.st = (volatile LAS unsigned*)(lds + LDS_BYTES - 64); xcd_barrier(bar_); } while (0)
#ifndef REPFIRST
#define REPFIRST 0
#endif
#define RUN(k, ...) do { if (REPFIRST && (((REPMASK) >> KIDX(k)) & 1)) { if (IN(k)) { const bool dry_ = freshi(1) != 0; (void)dry_; __VA_ARGS__ GBAR(); } } if (IN(k)) { const bool dry_ = false; (void)dry_; __VA_ARGS__ } if (!REPFIRST && (((REPMASK) >> KIDX(k)) & 1)) { if (IN(k)) { GBAR(); const bool dry_ = freshi(1) != 0; (void)dry_; __VA_ARGS__ } } } while (0)
    RUN(0, phase_prologue(P, lds, c, G););
    SEAM(0);
    RUN(1, {
        unsigned char* ws = fresh(args.P.ws);
        pg8::SchedKV S{(const char*)(ws + WS_MEMB), (const char*)(ws + WS_WK), (const char*)(ws + WS_WV), (bf16*)(ws + WS_KMAT), (bf16*)(ws + WS_VT), G, c};
        pg8::EpiStore E{0, 0, (unsigned*)(ws + WS_CTL) + CW_VBOUND};
        pg8::gemm_phase<pg8::EpiStore, pg8::SchedKV, false, false>(lds, 2048, S, E);
        if (c >= 128) phase_prologue_b(P, lds, c - 128, G - 128);
    });
    { constexpr int layer = 0;
        const int pb = 2 + 7 * layer;
        RUN(pb, {
            unsigned char* ws = fresh(args.P.ws);
            const int N = layer == 0 ? 1536 : 2048;
            pg8::SchedPlain S{(const char*)(ws + WS_XQ), (const char*)(ws + (layer == 0 ? WS_WINA : WS_WINB)), (bf16*)(ws + WS_Z), T / 256, N / 256, 1024, 1536, G, c, (bf16*)nullptr, (const float*)(ws + WS_XSCALE), (const float*)(ws + WS_CS) + (layer == 0 ? 0 : 2048), true};
            pg8::EpiStoreF8z E{layer == 0 ? 4 : 0, layer == 0 ? 99 : 2, layer == 0 ? 99 : 6};
            pg8::gemm_phase<pg8::EpiStoreF8z, pg8::SchedPlain, false, false, 1, true>(lds, 1024, S, E);
        });
        SEAM(pb);
        RUN(pb + 1, { for (int pair = c; pair < T / 256; pair += G) mixer_pair(P, lds, pair, layer); });
        LSEAM(pb + 1);
        RUN(pb + 2, {
            unsigned char* ws = fresh(args.P.ws);
            pg8::SchedPlain S{(const char*)(ws + WS_CAT), (const char*)(ws + WS_WOUT) + (size_t)layer * 1024 * 1024, (bf16*)(ws + WS_H1), T / 256, 4, 1024, 1024, G, c, (bf16*)nullptr, (const float*)(ws + WS_CSCALE), (const float*)(ws + WS_CSOUT) + layer * 1024, true};
            pg8::EpiResidI8 E{(const bf16*)(ws + WS_XB)};
            pg8::gemm_phase<pg8::EpiResidI8, pg8::SchedPlain, false, false, 1, true>(lds, 1024, S, E);
        });
        LSEAM(pb + 2);
        RUN(pb + 3, phase_ln1_router(P, lds, c, G, layer, dry_););
        SEAM(pb + 3);
        RUN(pb + 4, {
            unsigned char* ws = fresh(args.P.ws);
            const unsigned* cnt = (const unsigned*)(ws + WS_CTL) + CW_CNT + layer * 1024;
            const int NT = pg8::moe_tables(lds, cnt);
            pg8::SchedMoE S{lds, (const char*)(ws + WS_X1Q), (const char*)(ws + WS_WGU) + (size_t)layer * NE * 1024 * 1024, (size_t)1024 * 1024, 1024, (bf16*)(ws + WS_HMOE), DE, (const unsigned*)(ws + WS_LIST), NT, G, c, true, (const float*)(ws + WS_LSCL), (const float*)(ws + WS_CSGU) + layer * NE * 1024};
            pg8::EpiSwiGLUI8 E{};
            pg8::gemm_phase<pg8::EpiSwiGLUI8, pg8::SchedMoE, true, true, 1, true>(lds, 1024, S, E);
            if (layer == 0) late_convert(P, lds, c, G, NT, false);
        });
        SEAM(pb + 4);
        RUN(pb + 5, {
            unsigned char* ws = fresh(args.P.ws);
            const unsigned* cnt = (const unsigned*)(ws + WS_CTL) + CW_CNT + layer * 1024;
            const int NT = pg8::moe_tables(lds, cnt);
            pg8::SchedMoE S{lds, (const char*)(ws + WS_HMOE), (const char*)(ws + WS_WD) + (size_t)layer * NE * 1024 * 512, (size_t)1024 * 512, 512, (bf16*)(ws + WS_Y), 1024, (const unsigned*)(ws + WS_LIST), NT, G, c, false, (const float*)(ws + WS_LSCL), (const float*)(ws + WS_CSD) + layer * NE * 1024};
            pg8::EpiScatterF8 E{};
            pg8::gemm_phase<pg8::EpiScatterF8, pg8::SchedMoE, false, true, 2, true>(lds, 512, S, E);
            if (layer == 0) late_convert(P, lds, c, G, NT, true);
        });
        SEAM(pb + 5);
        RUN(pb + 6, phase_ln2(P, c, G, layer););
        LSEAM(pb + 6);
    }
    { constexpr int layer = 1;
        const int pb = 2 + 7 * layer;
        RUN(pb, {
            unsigned char* ws = fresh(args.P.ws);
            const int N = layer == 0 ? 1536 : 2048;
            pg8::SchedPlain S{(const char*)(ws + WS_XQ), (const char*)(ws + (layer == 0 ? WS_WINA : WS_WINB)), (bf16*)(ws + WS_Z), T / 256, N / 256, 1024, 1536, G, c, (bf16*)nullptr, (const float*)(ws + WS_XSCALE), (const float*)(ws + WS_CS) + (layer == 0 ? 0 : 2048), true};
            pg8::EpiStoreF8z E{layer == 0 ? 4 : 0, layer == 0 ? 99 : 2, layer == 0 ? 99 : 6};
            pg8::gemm_phase<pg8::EpiStoreF8z, pg8::SchedPlain, false, false, 1, true>(lds, 1024, S, E);
        });
        SEAM(pb);
        RUN(pb + 1, { for (int pair = c; pair < T / 256; pair += G) mixer_pair(P, lds, pair, layer); });
        LSEAM(pb + 1);
        RUN(pb + 2, {
            unsigned char* ws = fresh(args.P.ws);
            pg8::SchedPlain S{(const char*)(ws + WS_CAT), (const char*)(ws + WS_WOUT) + (size_t)layer * 1024 * 1024, (bf16*)(ws + WS_H1), T / 256, 4, 1024, 1024, G, c, (bf16*)nullptr, (const float*)(ws + WS_CSCALE), (const float*)(ws + WS_CSOUT) + layer * 1024, true};
            pg8::EpiResidI8 E{(const bf16*)(ws + WS_XB)};
            pg8::gemm_phase<pg8::EpiResidI8, pg8::SchedPlain, false, false, 1, true>(lds, 1024, S, E);
        });
        LSEAM(pb + 2);
        RUN(pb + 3, phase_ln1_router(P, lds, c, G, layer, dry_););
        SEAM(pb + 3);
        RUN(pb + 4, {
            unsigned char* ws = fresh(args.P.ws);
            const unsigned* cnt = (const unsigned*)(ws + WS_CTL) + CW_CNT + layer * 1024;
            const int NT = pg8::moe_tables(lds, cnt);
            pg8::SchedMoE S{lds, (const char*)(ws + WS_X1Q), (const char*)(ws + WS_WGU) + (size_t)layer * NE * 1024 * 1024, (size_t)1024 * 1024, 1024, (bf16*)(ws + WS_HMOE), DE, (const unsigned*)(ws + WS_LIST), NT, G, c, true, (const float*)(ws + WS_LSCL), (const float*)(ws + WS_CSGU) + layer * NE * 1024};
            pg8::EpiSwiGLUI8 E{};
            pg8::gemm_phase<pg8::EpiSwiGLUI8, pg8::SchedMoE, true, true, 1, true>(lds, 1024, S, E);
            if (layer == 0) late_convert(P, lds, c, G, NT, false);
        });
        SEAM(pb + 4);
        RUN(pb + 5, {
            unsigned char* ws = fresh(args.P.ws);
            const unsigned* cnt = (const unsigned*)(ws + WS_CTL) + CW_CNT + layer * 1024;
            const int NT = pg8::moe_tables(lds, cnt);
            pg8::SchedMoE S{lds, (const char*)(ws + WS_HMOE), (const char*)(ws + WS_WD) + (size_t)layer * NE * 1024 * 512, (size_t)1024 * 512, 512, (bf16*)(ws + WS_Y), 1024, (const unsigned*)(ws + WS_LIST), NT, G, c, false, (const float*)(ws + WS_LSCL), (const float*)(ws + WS_CSD) + layer * NE * 1024};
            pg8::EpiScatterF8 E{};
            pg8::gemm_phase<pg8::EpiScatterF8, pg8::SchedMoE, false, true, 2, true>(lds, 512, S, E);
            if (layer == 0) late_convert(P, lds, c, G, NT, true);
        });
        SEAM(pb + 5);
        RUN(pb + 6, phase_ln2(P, c, G, layer););
        LSEAM(pb + 6);
    }
#undef IN
#undef SEAM
#undef LSEAM
#undef RUN
#undef GBAR
#undef G
#undef c
}

extern "C" void kernel_launch(void* const* d_in, const int* in_sizes, int n_in, void* d_out, int out_size, void* d_ws, size_t ws_size, hipStream_t stream) {
    if (n_in != 20 || ws_size < WS_END) { fprintf(stderr, "kernel_launch: unexpected n_in %d or ws %zu\n", n_in, ws_size); return; }
    Args a{};
    const float** pp = (const float**)&a.P;
    for (int i = 0; i < 20; ++i) pp[i] = (const float*)d_in[i];
    a.P.out = (float*)d_out; a.P.ws = (unsigned char*)d_ws;
    unsigned char* ws = a.P.ws;
    static bool attr = false;
    if (!attr) { (void)hipFuncSetAttribute((const void*)mk_fwd, hipFuncAttributeMaxDynamicSharedMemorySize, LDS_BYTES); attr = true; }
    (void)hipMemsetAsync(ws + WS_CTL, 0, CTL_ZERO_BYTES, stream);
    a.ph_lo = 0; a.ph_hi = 16;
    hipLaunchKernelGGL(mk_fwd, dim3(256), dim3(512), LDS_BYTES, stream, a);
}
```

```cpp
#include <hip/hip_runtime.h>
#include <cstdio>
#include <cstdint>
#include <type_traits>

#define LAS __attribute__((address_space(3)))
typedef unsigned short bf16;
typedef short bf16x8 __attribute__((ext_vector_type(8)));
typedef float f32x4 __attribute__((ext_vector_type(4)));
typedef float f32x16 __attribute__((ext_vector_type(16)));
typedef unsigned u32x4 __attribute__((ext_vector_type(4)));
typedef unsigned u32x2 __attribute__((ext_vector_type(2)));
typedef float f32x2g __attribute__((ext_vector_type(2)));
typedef __bf16 bf16x2t __attribute__((ext_vector_type(2)));
typedef unsigned short u16x2 __attribute__((ext_vector_type(2)));

constexpr int T = 65536, D = 1024, MW = 512, SEQ = 4096, NBATCH = 16, NMEM = 256, NE = 16, DE = 512, NH = 4, HD = 128;
constexpr int NTOKMEM = NBATCH * NMEM;
constexpr float LN_EPS = 1e-5f;
constexpr float ALPHA = 1.41421356237f;
constexpr int MAXRT = 528;
constexpr float Y_SCALE = 16.f;

constexpr size_t MiB = 1u << 20;
constexpr size_t WS_CTL = 0, CTL_ZERO_BYTES = 1 * MiB;
constexpr size_t WS_WINA = 2 * MiB, WS_WINB = 5 * MiB, WS_WK = 9 * MiB, WS_WV = 11 * MiB, WS_WOUT = 13 * MiB, WS_WSGU = 17 * MiB;
constexpr size_t WS_WGU = 18 * MiB, WS_WD = 82 * MiB, WS_MEMB = 114 * MiB, WS_KMAT = 122 * MiB, WS_VT = 130 * MiB;
constexpr size_t WS_LIST = 138 * MiB, WS_GATES = 142 * MiB, WS_XB = 144 * MiB, WS_X1 = 272 * MiB, WS_H1 = 400 * MiB;
constexpr size_t WS_Z = 528 * MiB, WS_Y = WS_Z, WS_CAT = 784 * MiB, WS_HMOE = WS_CAT, WS_XQ = 920 * MiB  , WS_END = 984 * MiB;
constexpr size_t WS_CS = 1 * MiB;
constexpr size_t WS_XSCALE = 143 * MiB;
constexpr size_t WS_X1Q = 664 * MiB;
constexpr size_t WS_X1SCALE = 143 * MiB + 524288;
constexpr size_t WS_LSCL = 728 * MiB;
constexpr size_t WS_CSOUT = WS_CS + 163840;
constexpr size_t WS_CSCALE = 143 * MiB + 262144;
constexpr int CW_VBOUND = 12288;
constexpr int ROWSC_OFF = 139264;
constexpr size_t WS_CSD = WS_CS + 172032;
constexpr float Z_SCALE = 8.f;
#ifndef RES_Q8_L0
#define RES_Q8_L0 1
#endif
#ifndef RES_Q8_L1
#define RES_Q8_L1 1
#endif
constexpr float H_SCALE = 4.f;
constexpr size_t WS_CSGU = WS_CS + 16384;
typedef int i32x4 __attribute__((ext_vector_type(4)));
typedef int i32x8 __attribute__((ext_vector_type(8)));
constexpr int CW_CNT = 8192;

struct Ptrs {
    const float *x, *mem, *w_in_a, *sgu_ln_g, *sgu_ln_b, *sgu_w, *sgu_b, *w_in_b, *conv_w, *w_kv, *w_out, *ln1_g, *ln1_b, *router_w, *router_b, *w_gate, *w_up, *w_down, *ln2_g, *ln2_b;
    float* out; unsigned char* ws;
};

__device__ __forceinline__ unsigned char* fresh(unsigned char* p) { size_t z = 0; asm volatile("" : "+s"(z)); return p + z; }
__device__ __forceinline__ int freshi(int v) { asm volatile("" : "+s"(v)); return v; }
__device__ __forceinline__ unsigned f2bf(float f) { unsigned u = __builtin_bit_cast(unsigned, f); return (u + 0x7fffu + ((u >> 16) & 1u)) >> 16; }
__device__ __forceinline__ unsigned pk2(float lo, float hi) { return f2bf(lo) | (f2bf(hi) << 16); }
__device__ __forceinline__ float bf2f(unsigned short b) { return __builtin_bit_cast(float, (unsigned)b << 16); }
__device__ __forceinline__ float bflo(unsigned w) { return __builtin_bit_cast(float, w << 16); }
__device__ __forceinline__ float bfhi(unsigned w) { return __builtin_bit_cast(float, w & 0xffff0000u); }
__device__ __forceinline__ void unpack8(const u32x4 w, float* f) { f[0] = bflo(w.x); f[1] = bfhi(w.x); f[2] = bflo(w.y); f[3] = bfhi(w.y); f[4] = bflo(w.z); f[5] = bfhi(w.z); f[6] = bflo(w.w); f[7] = bfhi(w.w); }
__device__ __forceinline__ unsigned cvtpk2(float lo, float hi) { unsigned r; asm volatile("v_cvt_pk_bf16_f32 %0, %1, %2" : "=v"(r) : "v"(lo), "v"(hi)); return r; }
__device__ __forceinline__ u32x4 pack8(const float* f) { u32x4 w; w.x = cvtpk2(f[0], f[1]); w.y = cvtpk2(f[2], f[3]); w.z = cvtpk2(f[4], f[5]); w.w = cvtpk2(f[6], f[7]); return w; }
#define DPPF(v, ctrl) __builtin_bit_cast(float, __builtin_amdgcn_update_dpp(0, __builtin_bit_cast(int, (v)), (ctrl), 0xf, 0xf, false))
__device__ __forceinline__ float wave_sum(float v) {
    v += DPPF(v, 0xB1); v += DPPF(v, 0x4E); v += DPPF(v, 0x141); v += DPPF(v, 0x140);
    const int iv = __builtin_bit_cast(int, v);
    return (__builtin_bit_cast(float, __builtin_amdgcn_readlane(iv, 0)) + __builtin_bit_cast(float, __builtin_amdgcn_readlane(iv, 16))) + (__builtin_bit_cast(float, __builtin_amdgcn_readlane(iv, 32)) + __builtin_bit_cast(float, __builtin_amdgcn_readlane(iv, 48)));
}
__device__ __forceinline__ float wave_max(float v) {
    v = fmaxf(v, DPPF(v, 0xB1)); v = fmaxf(v, DPPF(v, 0x4E)); v = fmaxf(v, DPPF(v, 0x141)); v = fmaxf(v, DPPF(v, 0x140));
    const int iv = __builtin_bit_cast(int, v);
    return fmaxf(fmaxf(__builtin_bit_cast(float, __builtin_amdgcn_readlane(iv, 0)), __builtin_bit_cast(float, __builtin_amdgcn_readlane(iv, 16))), fmaxf(__builtin_bit_cast(float, __builtin_amdgcn_readlane(iv, 32)), __builtin_bit_cast(float, __builtin_amdgcn_readlane(iv, 48))));
}

__device__ __forceinline__ void transpose_item(const float* W, int ldn, int k0, int n0, bf16* WTrow0  , int K, LAS float* scr, int lane) {
#pragma unroll 8
    for (int i = 0; i < 32; ++i) { const int kk = 2 * i + (lane >> 5); scr[kk * 33 + (lane & 31)] = W[(size_t)(k0 + kk) * ldn + n0 + (lane & 31)]; }
    asm volatile("s_waitcnt lgkmcnt(0)" ::: "memory");
    const int c = lane & 7;
#pragma unroll
    for (int j = 0; j < 4; ++j) { const int n = (lane >> 3) + 8 * j; const LAS float* s = scr + (8 * c) * 33 + n;
        u32x4 o; o.x = pk2(s[0 * 33], s[1 * 33]); o.y = pk2(s[2 * 33], s[3 * 33]); o.z = pk2(s[4 * 33], s[5 * 33]); o.w = pk2(s[6 * 33], s[7 * 33]);
        *(u32x4*)(WTrow0 + (size_t)n * K + k0 + 8 * c) = o; }
    asm volatile("s_waitcnt lgkmcnt(0)" ::: "memory");
}
__device__ __forceinline__ int q8(float v) { int q = __float2int_rn(v); return q < -127 ? -127 : (q > 127 ? 127 : q); }
__device__ __forceinline__ unsigned pack4q(float a, float b, float c, float d) { const float M = 12582912.f;
    const unsigned ua = __builtin_bit_cast(unsigned, a + M), ub = __builtin_bit_cast(unsigned, b + M), uc = __builtin_bit_cast(unsigned, c + M), ud = __builtin_bit_cast(unsigned, d + M);
    return __builtin_amdgcn_perm(ub, ua, 0x0c0c0400u) | __builtin_amdgcn_perm(ud, uc, 0x04000c0cu); }
__device__ __forceinline__ unsigned pk4_fp8g(float a, float b, float c, float d) { int r = __builtin_amdgcn_cvt_pk_fp8_f32(a, b, 0, false); r = __builtin_amdgcn_cvt_pk_fp8_f32(c, d, r, true); return (unsigned)r; }
template <bool FP8 = false>
__device__ __forceinline__ void qtranspose_cols_wg(const float* W, int ldn, int n0, int K, signed char* dstrow0  , float* cs  , LAS float* scr, LAS float* part, int lane, int wave) {
    const int kw = K >> 3, kbeg = wave * kw, kr = lane >> 3, c4 = (lane & 7) * 4;
    f32x4 mx = (f32x4){0.f, 0.f, 0.f, 0.f};
#pragma unroll 4
    for (int k = kbeg; k < kbeg + kw; k += 8) { const f32x4 v = *(const f32x4*)(W + (size_t)(k + kr) * ldn + n0 + c4); mx.x = fmaxf(mx.x, fabsf(v.x)); mx.y = fmaxf(mx.y, fabsf(v.y)); mx.z = fmaxf(mx.z, fabsf(v.z)); mx.w = fmaxf(mx.w, fabsf(v.w)); }
#pragma unroll
    for (int o = 8; o < 64; o <<= 1) { mx.x = fmaxf(mx.x, __shfl_xor(mx.x, o)); mx.y = fmaxf(mx.y, __shfl_xor(mx.y, o)); mx.z = fmaxf(mx.z, __shfl_xor(mx.z, o)); mx.w = fmaxf(mx.w, __shfl_xor(mx.w, o)); }
    if (lane < 8) *(LAS f32x4*)(part + wave * 32 + c4) = mx;
    __syncthreads();
    const int n = lane >> 1; float cm = 0.f;
#pragma unroll
    for (int w = 0; w < 8; ++w) cm = fmaxf(cm, part[w * 32 + n]);
    const float scale = cm > 0.f ? cm * (FP8 ? 1.f / 256.f : 1.f / 127.f) : 1.f, invn = 1.f / scale;
    if (wave == 0 && (lane & 1) == 0) cs[n] = scale;
    for (int k0 = kbeg; k0 < kbeg + kw; k0 += 64) {
        f32x4 ld[8];
#pragma unroll
        for (int i = 0; i < 8; ++i) ld[i] = *(const f32x4*)(W + (size_t)(k0 + 8 * i + kr) * ldn + n0 + c4);
#pragma unroll
        for (int i = 0; i < 8; ++i) { LAS float* sp = scr + (8 * i + kr) * 33 + c4; sp[0] = ld[i].x; sp[1] = ld[i].y; sp[2] = ld[i].z; sp[3] = ld[i].w; }
        asm volatile("s_waitcnt lgkmcnt(0)" ::: "memory");
#pragma unroll
        for (int jj = 0; jj < 2; ++jj) { const int cidx = (lane & 1) * 2 + jj; const LAS float* sp = scr + (16 * cidx) * 33 + n;
            u32x4 o;
            if constexpr (FP8) { o.x = pk4_fp8g(sp[0] * invn, sp[33] * invn, sp[66] * invn, sp[99] * invn); o.y = pk4_fp8g(sp[132] * invn, sp[165] * invn, sp[198] * invn, sp[231] * invn);
                o.z = pk4_fp8g(sp[264] * invn, sp[297] * invn, sp[330] * invn, sp[363] * invn); o.w = pk4_fp8g(sp[396] * invn, sp[429] * invn, sp[462] * invn, sp[495] * invn); }
            else { o.x = pack4q(sp[0] * invn, sp[33] * invn, sp[66] * invn, sp[99] * invn); o.y = pack4q(sp[132] * invn, sp[165] * invn, sp[198] * invn, sp[231] * invn);
                o.z = pack4q(sp[264] * invn, sp[297] * invn, sp[330] * invn, sp[363] * invn); o.w = pack4q(sp[396] * invn, sp[429] * invn, sp[462] * invn, sp[495] * invn); }
            *(u32x4*)(dstrow0 + (size_t)n * K + k0 + 16 * cidx) = o; }
        asm volatile("s_waitcnt lgkmcnt(0)" ::: "memory");
    }
    __syncthreads();
}
constexpr int QIT_INA = 48, QIT_INB = 64, QIT_GU = 16 * 2 * 16  , QIT_OUT = 2 * 32, QIT_TOTAL = QIT_INA + QIT_INB + QIT_GU + QIT_OUT;
constexpr int IT_INA = 0, IT_INB = 0, IT_KV = 2 * 16 * 32, IT_OUT = 2 * 16 * 32, IT_G = 0, IT_U = 0, IT_DN = 32 * 8 * 32;
constexpr int IT_TOTAL = IT_INA + IT_INB + IT_KV + IT_OUT + IT_G + IT_U + IT_DN;

#ifndef PRO_B_ALL
#define PRO_B_ALL 1
#endif
__device__ __forceinline__ void phase_prologue(const Ptrs& P, LAS unsigned char* lds, int c, int G, int part) {
    int tid_ = threadIdx.x; asm volatile("" : "+v"(tid_));
    const int tid = tid_, lane = tid & 63, wave = tid >> 6, nw = blockDim.x >> 6;
    unsigned char* ws = fresh(P.ws);
    LAS float* scr = (LAS float*)(lds + wave * 8704);
    const int gw = c * nw + wave, NGW = G * nw;
    if (part == 0) { LAS float* part = (LAS float*)(lds + 8 * 8704);
      for (int qj = c; qj < QIT_INA + (PRO_B_ALL ? 0 : QIT_INB + QIT_OUT); qj += G) { const int qi = qj < QIT_INA + QIT_INB ? qj : qj + QIT_GU;
        if (qi < QIT_INA) qtranspose_cols_wg(P.w_in_a, 1536, qi * 32, 1024, (signed char*)(ws + WS_WINA) + (size_t)(qi * 32) * 1024, (float*)(ws + WS_CS) + qi * 32, scr, part, lane, wave);
        else if (qi < QIT_INA + QIT_INB) { const int q2 = qi - QIT_INA, n0 = q2 * 32;
            int drow = n0; if (n0 >= 512 && n0 < 1536) { const int j = (n0 - 512) & 511, isx = n0 >= 1024; drow = 512 + 256 * (j >> 7) + 64 * ((j & 127) >> 5) + (isx ? 32 : 0); }
            qtranspose_cols_wg(P.w_in_b, 2048, n0, 1024, (signed char*)(ws + WS_WINB) + (size_t)drow * 1024, (float*)(ws + WS_CS) + 2048 + drow, scr, part, lane, wave); }
        else if (qi >= QIT_INA + QIT_INB + QIT_GU) { const int q4 = qi - QIT_INA - QIT_INB - QIT_GU, l = q4 >> 5, nb = q4 & 31;
            qtranspose_cols_wg(P.w_out + (size_t)l * 1024 * 1024, 1024, nb * 32, 1024, (signed char*)(ws + WS_WOUT) + (size_t)l * 1024 * 1024 + (size_t)(nb * 32) * 1024, (float*)(ws + WS_CSOUT) + l * 1024 + nb * 32, scr, part, lane, wave); }
        else { const int q3 = qi - QIT_INA - QIT_INB, le = q3 >> 5, up = (q3 >> 4) & 1, nb = q3 & 15, n0 = nb * 32, drow = (n0 >> 7) * 256 + (up ? 128 : 0) + (n0 & 127);
            qtranspose_cols_wg((up ? P.w_up : P.w_gate) + (size_t)le * 1024 * 512, 512, n0, 1024, (signed char*)(ws + WS_WGU) + (size_t)le * 1024 * 1024 + (size_t)drow * 1024, (float*)(ws + WS_CSGU) + le * 1024 + drow, scr, part, lane, wave); } } }
    if (part == 0) for (int it = gw; it < IT_KV; it += NGW) {
        int r = it;
        if (r < IT_KV) { const int l = r / 512, q = r % 512, kb = q / 32, nb = q % 32; const int n0 = nb * 32;
            bf16* dst = (n0 < 512) ? (bf16*)(ws + WS_WK) + (size_t)(l * 512 + n0) * 1024 : (bf16*)(ws + WS_WV) + (size_t)(l * 512 + n0 - 512) * 1024;
            transpose_item(P.w_kv + (size_t)l * 1024 * 1024, 1024, kb * 64, n0, dst, 1024, scr, lane); }
    }
    const size_t gt = (size_t)c * blockDim.x + tid, NT = (size_t)G * blockDim.x;
    if (part == 1) { const size_t rend = (size_t)(c + 1) * 256;
    f32x4 na, nb, nc, nd; { const f32x4* xr = (const f32x4*)(P.x + ((size_t)c * 256 + wave) * D + lane * 16); na = xr[0]; nb = xr[1]; nc = xr[2]; nd = xr[3]; }
    for (size_t row = (size_t)c * 256 + wave; row < rend; row += nw) { const f32x4 a = na, b = nb, cc = nc, d = nd;
        { const size_t rn = row + nw < rend ? row + nw : row; const f32x4* xr = (const f32x4*)(P.x + rn * D + lane * 16); na = xr[0]; nb = xr[1]; nc = xr[2]; nd = xr[3]; }
        if (!RES_Q8_L0) {u32x4 o0, o1; o0.x = pk2(a.x, a.y); o0.y = pk2(a.z, a.w); o0.z = pk2(b.x, b.y); o0.w = pk2(b.z, b.w); o1.x = pk2(cc.x, cc.y); o1.y = pk2(cc.z, cc.w); o1.z = pk2(d.x, d.y); o1.w = pk2(d.z, d.w);
        u32x4* xbp = (u32x4*)(ws + WS_XB + (row * D + lane * 16) * 2); xbp[0] = o0; xbp[1] = o1; }
        float mx = fmaxf(fmaxf(fmaxf(fabsf(a.x), fabsf(a.y)), fmaxf(fabsf(a.z), fabsf(a.w))), fmaxf(fmaxf(fabsf(b.x), fabsf(b.y)), fmaxf(fabsf(b.z), fabsf(b.w))));
        mx = fmaxf(mx, fmaxf(fmaxf(fmaxf(fabsf(cc.x), fabsf(cc.y)), fmaxf(fabsf(cc.z), fabsf(cc.w))), fmaxf(fmaxf(fabsf(d.x), fabsf(d.y)), fmaxf(fabsf(d.z), fabsf(d.w)))));
        mx = wave_max(mx); const float scale = mx > 0.f ? mx * (1.f / 127.f) : 1.f, inv = 1.f / scale;
        u32x4 q; q.x = pack4q(a.x * inv, a.y * inv, a.z * inv, a.w * inv); q.y = pack4q(b.x * inv, b.y * inv, b.z * inv, b.w * inv); q.z = pack4q(cc.x * inv, cc.y * inv, cc.z * inv, cc.w * inv); q.w = pack4q(d.x * inv, d.y * inv, d.z * inv, d.w * inv);
        *(u32x4*)(ws + WS_XQ + row * D + lane * 16) = q; if (lane == 0) ((float*)(ws + WS_XSCALE))[row] = scale; }
    return; }
    for (size_t i = gt; i < (size_t)NTOKMEM * D / 8; i += NT) { const f32x4 a = ((const f32x4*)P.mem)[2 * i], b = ((const f32x4*)P.mem)[2 * i + 1];
        u32x4 o; o.x = pk2(a.x, a.y); o.y = pk2(a.z, a.w); o.z = pk2(b.x, b.y); o.w = pk2(b.z, b.w); ((u32x4*)(ws + WS_MEMB))[i] = o; }
    for (size_t i = gt; i < (size_t)NH * 128 * 128; i += NT) { const int hh = (int)(i >> 14), ii = (int)(i >> 7) & 127, pos = (int)i & 127, kb = pos >> 5, g = (pos >> 3) & 3, jj = pos & 7;
        const int j = 32 * kb + (jj < 4 ? 4 * g + jj : 16 + 4 * g + (jj - 4));
        const float v = ((ii >> 6) >= (j >> 6)) ? P.sgu_w[(size_t)(hh * 128 + ii) * 128 + j] : 0.f; ((bf16*)(ws + WS_WSGU))[i] = (bf16)f2bf(v * (1.f / Z_SCALE)); }
}

__device__ __forceinline__ void phase_prologue_b(const Ptrs& P, LAS unsigned char* lds, int c, int G) {
    int tid_ = threadIdx.x; asm volatile("" : "+v"(tid_));
    const int tid = tid_, lane = tid & 63, wave = tid >> 6, nw = blockDim.x >> 6;
    unsigned char* ws = fresh(P.ws);
    LAS float* scr = (LAS float*)(lds + wave * 8704);
    const int gw = c * nw + wave, NGW = G * nw;
    LAS float* part = (LAS float*)(lds + 8 * 8704);
    for (int qi = c; qi < 16 * 32; qi += G) { const int le = qi >> 5, nb = qi & 31;
        qtranspose_cols_wg<true>(P.w_down + (size_t)le * 512 * 1024, 1024, nb * 32, 512, (signed char*)(ws + WS_WD) + (size_t)le * 1024 * 512 + (size_t)(nb * 32) * 512, (float*)(ws + WS_CSD) + le * 1024 + nb * 32, scr, part, lane, wave); }
    for (int q3 = c; q3 < QIT_GU; q3 += G) { const int le = q3 >> 5, up = (q3 >> 4) & 1, nb = q3 & 15, n0 = nb * 32, drow = (n0 >> 7) * 256 + (up ? 128 : 0) + (n0 & 127);
        qtranspose_cols_wg((up ? P.w_up : P.w_gate) + (size_t)le * 1024 * 512, 512, n0, 1024, (signed char*)(ws + WS_WGU) + (size_t)le * 1024 * 1024 + (size_t)drow * 1024, (float*)(ws + WS_CSGU) + le * 1024 + drow, scr, part, lane, wave); }
    if (PRO_B_ALL) for (int q = c; q < QIT_INB + QIT_OUT; q += G) {
        if (q < QIT_INB) { const int n0 = q * 32;
            int drow = n0; if (n0 >= 512 && n0 < 1536) { const int j = (n0 - 512) & 511, isx = n0 >= 1024; drow = 512 + 256 * (j >> 7) + 64 * ((j & 127) >> 5) + (isx ? 32 : 0); }
            qtranspose_cols_wg(P.w_in_b, 2048, n0, 1024, (signed char*)(ws + WS_WINB) + (size_t)drow * 1024, (float*)(ws + WS_CS) + 2048 + drow, scr, part, lane, wave); }
        else { const int q4 = q - QIT_INB, l = q4 >> 5, nb = q4 & 31;
            qtranspose_cols_wg(P.w_out + (size_t)l * 1024 * 1024, 1024, nb * 32, 1024, (signed char*)(ws + WS_WOUT) + (size_t)l * 1024 * 1024 + (size_t)(nb * 32) * 1024, (float*)(ws + WS_CSOUT) + l * 1024 + nb * 32, scr, part, lane, wave); } }
    (void)gw; (void)NGW; (void)tid;
}

__device__ __forceinline__ void late_convert(const Ptrs& P, LAS unsigned char* lds, int c, int G, int NT, bool down) {
    int tid_ = threadIdx.x; asm volatile("" : "+v"(tid_));
    const int tid = tid_, lane = tid & 63, wave = tid >> 6;
    unsigned char* ws = fresh(P.ws);
    LAS float* scr = (LAS float*)(lds + wave * 8704); LAS float* part = (LAS float*)(lds + 8 * 8704);
    const int units = NT * 4, rounds = (units + G - 1) / G, nextra = units - (rounds - 1) * G;
    int w0 = nextra, nwork = G - nextra; if (nwork < 64) { w0 = 0; nwork = G; }
    if (c < w0) return;
    for (int q = c - w0; q < 512; q += nwork) {
        if (!down) { const int q3 = 512 + q, le = q3 >> 5, up = (q3 >> 4) & 1, nb = q3 & 15, n0 = nb * 32, drow = (n0 >> 7) * 256 + (up ? 128 : 0) + (n0 & 127);
            qtranspose_cols_wg((up ? P.w_up : P.w_gate) + (size_t)le * 1024 * 512, 512, n0, 1024, (signed char*)(ws + WS_WGU) + (size_t)le * 1024 * 1024 + (size_t)drow * 1024, (float*)(ws + WS_CSGU) + le * 1024 + drow, scr, part, lane, wave); }
        else { const int qi = 512 + q, le = qi >> 5, nb = qi & 31;
            qtranspose_cols_wg<true>(P.w_down + (size_t)le * 512 * 1024, 1024, nb * 32, 512, (signed char*)(ws + WS_WD) + (size_t)le * 1024 * 512 + (size_t)(nb * 32) * 512, (float*)(ws + WS_CSD) + le * 1024 + nb * 32, scr, part, lane, wave); }
    }
}

__device__ __forceinline__ unsigned cvtpk(float lo, float hi) { unsigned r; asm volatile("v_cvt_pk_bf16_f32 %0, %1, %2" : "=v"(r) : "v"(lo), "v"(hi)); return r; }
__device__ __forceinline__ void phase_ln1_router(const Ptrs& P, LAS unsigned char* lds, int c, int G, int layer, bool dry) {
    int tid_ = threadIdx.x; asm volatile("" : "+v"(tid_));
    const int tid = tid_, lane = tid & 63, wave = tid >> 6, l15 = lane & 15, g = lane >> 4;
    unsigned char* ws = fresh(P.ws);
    LAS unsigned char* rwh = lds; LAS unsigned char* rwl = lds + 32768;
    LAS float* gam = (LAS float*)(lds + 65536); LAS float* bet = (LAS float*)(lds + 65536 + 4096);
    LAS int* hist = (LAS int*)(lds + 73728);
    LAS int* base = (LAS int*)(lds + 73728 + 64);
    LAS int* loc_e = (LAS int*)(lds + 73728 + 128);
    LAS int* loc_s = (LAS int*)(lds + 73728 + 128 + 2048);
    LAS float* lgt = (LAS float*)(lds + 73728 + 128 + 4096);
    LAS float* rsc = (LAS float*)(lds + 73728 + 128 + 4096 + 20480);
    const bf16* H1 = (const bf16*)(ws + WS_H1); bf16* X1 = (bf16*)(ws + WS_X1); (void)X1;
    unsigned* cnt = (unsigned*)(ws + WS_CTL) + CW_CNT + layer * 1024;
    unsigned* list = (unsigned*)(ws + WS_LIST); float* gates = (float*)(ws + WS_GATES);
    const int rb = c; (void)G;
    const float gv0 = P.ln1_g[layer * D + tid], gv1 = P.ln1_g[layer * D + 512 + tid], bv0 = P.ln1_b[layer * D + tid], bv1 = P.ln1_b[layer * D + 512 + tid];
    u32x4 raw[32];
    { const size_t row = (size_t)rb * 256 + wave * 32 + l15;
#pragma unroll
      for (int ks = 0; ks < 32; ++ks) raw[ks] = *(const u32x4*)(H1 + row * D + 32 * ks + 8 * g); }
    __builtin_amdgcn_sched_barrier(0);
#pragma unroll 4
    for (int k = 0; k < 32; ++k) { const int i = tid + 512 * k; const float w = P.router_w[i]; const int col = i >> 4, e = i & 15; const unsigned hb = f2bf(w); const float hf = __builtin_bit_cast(float, hb << 16);
        const int off = e * 2048 + ((((col >> 3) ^ e)) << 4) + (col & 7) * 2; *(LAS unsigned short*)(rwh + off) = (unsigned short)hb; *(LAS unsigned short*)(rwl + off) = (unsigned short)f2bf(w - hf); }
    gam[tid] = gv0; gam[512 + tid] = gv1; bet[tid] = bv0; bet[512 + tid] = bv1;
    if (tid < 16) hist[tid] = 0;
    __syncthreads();
    float gmax = 0.f, bmax = 0.f;
#pragma unroll
    for (int j = 0; j < 16; ++j) { gmax = fmaxf(gmax, fabsf(gam[lane * 16 + j])); bmax = fmaxf(bmax, fabsf(bet[lane * 16 + j])); }
    gmax = wave_max(gmax); bmax = wave_max(bmax);
    {
        auto group = [&](auto pf, const int grp) {
            constexpr bool PF = decltype(pf)::value;
            int lane_g = lane; asm volatile("" : "+v"(lane_g)); const int l15 = lane_g & 15, g = lane_g >> 4;
            const int rl0 = wave * 32 + grp * 16; const size_t row = (size_t)rb * 256 + rl0 + l15;
            float s1a = 0.f, s1b = 0.f, s2a = 0.f, s2b = 0.f; u16x2 mxa = (u16x2){0, 0}, mxb = (u16x2){0, 0};
            const bf16x2t ones2 = __builtin_bit_cast(bf16x2t, 0x3f803f80u);
#pragma unroll
            for (int ks = 0; ks < 32; ++ks) { const unsigned w0 = raw[ks].x, w1 = raw[ks].y, w2 = raw[ks].z, w3 = raw[ks].w;
                const bf16x2t p0 = __builtin_bit_cast(bf16x2t, w0), p1 = __builtin_bit_cast(bf16x2t, w1), p2 = __builtin_bit_cast(bf16x2t, w2), p3 = __builtin_bit_cast(bf16x2t, w3);
                s1a = __builtin_amdgcn_fdot2_f32_bf16(p0, ones2, s1a, false); s1b = __builtin_amdgcn_fdot2_f32_bf16(p1, ones2, s1b, false); s1a = __builtin_amdgcn_fdot2_f32_bf16(p2, ones2, s1a, false); s1b = __builtin_amdgcn_fdot2_f32_bf16(p3, ones2, s1b, false);
                s2a = __builtin_amdgcn_fdot2_f32_bf16(p0, p0, s2a, false); s2b = __builtin_amdgcn_fdot2_f32_bf16(p1, p1, s2b, false); s2a = __builtin_amdgcn_fdot2_f32_bf16(p2, p2, s2a, false); s2b = __builtin_amdgcn_fdot2_f32_bf16(p3, p3, s2b, false);
                mxa = __builtin_elementwise_max(mxa, __builtin_bit_cast(u16x2, w0 & 0x7fff7fffu)); mxb = __builtin_elementwise_max(mxb, __builtin_bit_cast(u16x2, w1 & 0x7fff7fffu));
                mxa = __builtin_elementwise_max(mxa, __builtin_bit_cast(u16x2, w2 & 0x7fff7fffu)); mxb = __builtin_elementwise_max(mxb, __builtin_bit_cast(u16x2, w3 & 0x7fff7fffu)); }
            float s1 = s1a + s1b, s2 = s2a + s2b; const unsigned mxw = __builtin_bit_cast(unsigned, __builtin_elementwise_max(mxa, mxb)); float amax = fmaxf(bflo(mxw), bfhi(mxw));
            s1 += __shfl_xor(s1, 16); s1 += __shfl_xor(s1, 32); s2 += __shfl_xor(s2, 16); s2 += __shfl_xor(s2, 32);
            amax = fmaxf(amax, __shfl_xor(amax, 16)); amax = fmaxf(amax, __shfl_xor(amax, 32));
            const float mean = s1 * (1.f / D); const float rstd = rsqrtf(fmaxf(s2 * (1.f / D) - mean * mean, 0.f) + LN_EPS); const float nmr = -mean * rstd;
            const float amb = gmax * rstd * (amax + fabsf(mean)) + bmax; const float qscale = amb > 0.f ? amb * (1.f / 127.f) : 1.f, qinv = 1.f / qscale;
            if (g == 0) { rsc[rl0 + l15] = qscale; ((float*)(ws + WS_X1SCALE))[row] = qscale; }
            signed char* XQ1 = (signed char*)(ws + WS_X1Q);
            f32x4 acc = (f32x4){0.f, 0.f, 0.f, 0.f};
#pragma unroll
            for (int ks = 0; ks < 32; ++ks) {
                if (PF || (ks & 1) == 0) __builtin_amdgcn_sched_barrier(0);
                u32x4 rk = raw[ks]; asm volatile("" : "+v"(rk));
                if (PF) raw[ks] = *(const u32x4*)(H1 + (row + 16) * D + 32 * ks + 8 * g);
                float v[8]; unpack8(rk, v);
                const f32x4 g0 = *(const LAS f32x4*)(gam + 32 * ks + 8 * g), g1 = *(const LAS f32x4*)(gam + 32 * ks + 8 * g + 4), b0 = *(const LAS f32x4*)(bet + 32 * ks + 8 * g), b1 = *(const LAS f32x4*)(bet + 32 * ks + 8 * g + 4);
                float x[8];
#pragma unroll
                for (int j = 0; j < 8; ++j) { const float gj = j < 4 ? g0[j & 3] : g1[j & 3], bj = j < 4 ? b0[j & 3] : b1[j & 3]; x[j] = (v[j] * rstd + nmr) * gj + bj; }
                { u32x2 qw; qw.x = pack4q(x[0] * qinv, x[1] * qinv, x[2] * qinv, x[3] * qinv); qw.y = pack4q(x[4] * qinv, x[5] * qinv, x[6] * qinv, x[7] * qinv); *(u32x2*)(XQ1 + row * D + 32 * ks + 8 * g) = qw; }
                u32x4 hw; hw.x = cvtpk(x[0], x[1]); hw.y = cvtpk(x[2], x[3]); hw.z = cvtpk(x[4], x[5]); hw.w = cvtpk(x[6], x[7]);
                float hf[8]; unpack8(hw, hf);
                u32x4 lw; lw.x = cvtpk(x[0] - hf[0], x[1] - hf[1]); lw.y = cvtpk(x[2] - hf[2], x[3] - hf[3]); lw.z = cvtpk(x[4] - hf[4], x[5] - hf[5]); lw.w = cvtpk(x[6] - hf[6], x[7] - hf[7]);
                const int boff = l15 * 2048 + (((4 * ks + g) ^ l15) << 4);
                const bf16x8 bh = *(const LAS bf16x8*)(rwh + boff), bl = *(const LAS bf16x8*)(rwl + boff);
                const bf16x8 ah = __builtin_bit_cast(bf16x8, hw), al = __builtin_bit_cast(bf16x8, lw);
                acc = __builtin_amdgcn_mfma_f32_16x16x32_bf16(ah, bh, acc, 0, 0, 0);
                acc = __builtin_amdgcn_mfma_f32_16x16x32_bf16(ah, bl, acc, 0, 0, 0);
                acc = __builtin_amdgcn_mfma_f32_16x16x32_bf16(al, bh, acc, 0, 0, 0);
            }
#pragma unroll
            for (int r = 0; r < 4; ++r) lgt[(rl0 + 4 * g + r) * 20 + l15] = acc[r];
        };
        group(std::true_type{}, 0);
        __builtin_amdgcn_sched_barrier(0);
        group(std::false_type{}, 1);
        __syncthreads();
        if (tid < 256) {
            const int rl = tid; const size_t row = (size_t)rb * 256 + rl;
            float sc[16], se[16];
#pragma unroll
            for (int q4 = 0; q4 < 4; ++q4) { const f32x4 lv = *(const LAS f32x4*)(lgt + rl * 20 + 4 * q4); const f32x4 rbv = ((const f32x4*)P.router_b)[q4];
#pragma unroll
                for (int k = 0; k < 4; ++k) { const float scv = 1.f / (1.f + __expf(-lv[k])); sc[4 * q4 + k] = scv; se[4 * q4 + k] = scv + rbv[k]; } }
            int bg = 0; float bgs = -3.0e38f;
#pragma unroll
            for (int gq = 0; gq < 4; ++gq) { const float a = se[4 * gq], b = se[4 * gq + 1], cc = se[4 * gq + 2], d = se[4 * gq + 3];
                const float mx = fmaxf(fmaxf(a, b), fmaxf(cc, d));
                const float lo1 = fminf(a, b), hi1 = fmaxf(a, b), lo2 = fminf(cc, d), hi2 = fmaxf(cc, d); const float second = fmaxf(fminf(hi1, hi2), fmaxf(lo1, lo2));
                const float gs = mx + second; if (gs > bgs) { bgs = gs; bg = gq; } }
            float s0 = 0.f, s1 = 0.f, s2 = 0.f, s3 = 0.f, c0 = 0.f, c1 = 0.f, c2 = 0.f, c3 = 0.f;
#pragma unroll
            for (int gq = 0; gq < 4; ++gq) if (bg == gq) { s0 = se[4 * gq]; s1 = se[4 * gq + 1]; s2 = se[4 * gq + 2]; s3 = se[4 * gq + 3]; c0 = sc[4 * gq]; c1 = sc[4 * gq + 1]; c2 = sc[4 * gq + 2]; c3 = sc[4 * gq + 3]; }
            int i0 = 0; float m0 = s0; if (s1 > m0) { m0 = s1; i0 = 1; } if (s2 > m0) { m0 = s2; i0 = 2; } if (s3 > m0) { m0 = s3; i0 = 3; }
            int i1 = -1; float m1 = -3.0e38f;
            if (i0 != 0 && s0 > m1) { m1 = s0; i1 = 0; } if (i0 != 1 && s1 > m1) { m1 = s1; i1 = 1; } if (i0 != 2 && s2 > m1) { m1 = s2; i1 = 2; } if (i0 != 3 && s3 > m1) { m1 = s3; i1 = 3; }
            const float sc0 = i0 == 0 ? c0 : i0 == 1 ? c1 : i0 == 2 ? c2 : c3, sc1 = i1 == 0 ? c0 : i1 == 1 ? c1 : i1 == 2 ? c2 : c3;
            const float inv = 1.f / (sc0 + sc1);
            if (!dry) { const int e0 = bg * 4 + i0, e1 = bg * 4 + i1;
                const int sl0 = __hip_atomic_fetch_add(hist + e0, 1, __ATOMIC_RELAXED, __HIP_MEMORY_SCOPE_WORKGROUP), sl1 = __hip_atomic_fetch_add(hist + e1, 1, __ATOMIC_RELAXED, __HIP_MEMORY_SCOPE_WORKGROUP);
                loc_e[2 * rl] = e0; loc_s[2 * rl] = sl0; loc_e[2 * rl + 1] = e1; loc_s[2 * rl + 1] = sl1;
                *(f32x2g*)(gates + row * 2) = (f32x2g){sc0 * inv, sc1 * inv}; }
        }
        __syncthreads();
        if (tid < 16 && !dry) base[tid] = (int)atomicAdd(&cnt[64 * tid], (unsigned)hist[tid]);
        __syncthreads();
        if (!dry) { const int e = loc_e[tid]; const size_t li = (size_t)e * T + base[e] + loc_s[tid]; list[li] = (unsigned)(rb * 512 + tid); ((float*)(ws + WS_LSCL))[li] = rsc[tid >> 1]; }
        __syncthreads();
        if (tid < 16) hist[tid] = 0;
        __syncthreads();
    }
}

__device__ __forceinline__ void unpack_fp8x8(const u32x2 w, float* f) {
    const auto l0 = __builtin_amdgcn_cvt_pk_f32_fp8((int)w.x, false); const auto h0 = __builtin_amdgcn_cvt_pk_f32_fp8((int)w.x, true); const auto l1 = __builtin_amdgcn_cvt_pk_f32_fp8((int)w.y, false); const auto h1 = __builtin_amdgcn_cvt_pk_f32_fp8((int)w.y, true);
    f[0] = l0[0]; f[1] = l0[1]; f[2] = h0[0]; f[3] = h0[1]; f[4] = l1[0]; f[5] = l1[1]; f[6] = h1[0]; f[7] = h1[1];
}
__device__ __forceinline__ void unpack_fp8x16(const u32x4 w, float* f) {
    const unsigned ww[4] = {w.x, w.y, w.z, w.w};
#pragma unroll
    for (int k = 0; k < 4; ++k) { const auto lo = __builtin_amdgcn_cvt_pk_f32_fp8((int)ww[k], false); const auto hi = __builtin_amdgcn_cvt_pk_f32_fp8((int)ww[k], true); f[4 * k] = lo[0]; f[4 * k + 1] = lo[1]; f[4 * k + 2] = hi[0]; f[4 * k + 3] = hi[1]; }
}
__device__ __forceinline__ void phase_ln2(const Ptrs& P, int c, int G, int layer) {
    int tid_ = threadIdx.x; asm volatile("" : "+v"(tid_));
    const int tid = tid_, lane = tid & 63, wave = tid >> 6, nw = blockDim.x >> 6;
    unsigned char* ws = fresh(P.ws);
    const unsigned char* X1Q = (const unsigned char*)(ws + WS_X1Q); const float* X1S = (const float*)(ws + WS_X1SCALE); const unsigned char* Y8 = (const unsigned char*)(ws + WS_Y); const float* gates = (const float*)(ws + WS_GATES);
    bf16* XB = (bf16*)(ws + WS_XB);
    const float* g2 = P.ln2_g + layer * D; const float* b2 = P.ln2_b + layer * D;
    float gg[16], bb[16];
#pragma unroll
    for (int j = 0; j < 16; ++j) { gg[j] = g2[lane * 16 + j]; bb[j] = b2[lane * 16 + j]; }
    const size_t rstep = (size_t)nw, rend = (size_t)(c + 1) * 256; size_t row = (size_t)c * 256 + wave; (void)G;
    u32x4 nx0 = *(const u32x4*)(X1Q + row * D + lane * 16), ny0 = *(const u32x4*)(Y8 + (row * 2) * 1024 + lane * 16), ny1 = *(const u32x4*)(Y8 + (row * 2 + 1) * 1024 + lane * 16);
    f32x2g ngt = *(const f32x2g*)(gates + row * 2); float nxs = X1S[row];
    for (; row < rend; row += rstep) {
        float v[16], a[16], b[16];
        const u32x4 cx0 = nx0, cy0 = ny0, cy1 = ny1; const f32x2g cgt = ngt; const float cxs = nxs;
        { const size_t rn = row + rstep < rend ? row + rstep : row;
          nx0 = *(const u32x4*)(X1Q + rn * D + lane * 16); ny0 = *(const u32x4*)(Y8 + (rn * 2) * 1024 + lane * 16); ny1 = *(const u32x4*)(Y8 + (rn * 2 + 1) * 1024 + lane * 16);
          ngt = *(const f32x2g*)(gates + rn * 2); nxs = X1S[rn]; }
        unpack_fp8x16(cy0, a); unpack_fp8x16(cy1, b);
        {
            const unsigned wq[4] = {cx0.x ^ 0x80808080u, cx0.y ^ 0x80808080u, cx0.z ^ 0x80808080u, cx0.w ^ 0x80808080u}; const float as = ALPHA * cxs, ao = -128.f * as;
#pragma unroll
            for (int k = 0; k < 4; ++k) { v[4 * k] = (float)(wq[k] & 255u) * as + ao; v[4 * k + 1] = (float)((wq[k] >> 8) & 255u) * as + ao; v[4 * k + 2] = (float)((wq[k] >> 16) & 255u) * as + ao; v[4 * k + 3] = (float)(wq[k] >> 24) * as + ao; } }
        const float ga = cgt[0] * (1.f / Y_SCALE), gb = cgt[1] * (1.f / Y_SCALE);
        float s = 0.f;
#pragma unroll
        for (int j = 0; j < 16; ++j) { v[j] = v[j] + (ga * a[j] + gb * b[j]); s += v[j]; }
        const float mean = wave_sum(s) * (1.f / D); float q = 0.f;
#pragma unroll
        for (int j = 0; j < 16; ++j) { v[j] -= mean; q += v[j] * v[j]; }
        const float rstd = rsqrtf(wave_sum(q) * (1.f / D) + LN_EPS);
#pragma unroll
        for (int j = 0; j < 16; ++j) v[j] = v[j] * rstd * gg[j] + bb[j];
        if (layer == 0) { if (!RES_Q8_L1) { *(u32x4*)(XB + row * D + lane * 16) = pack8(v); *(u32x4*)(XB + row * D + lane * 16 + 8) = pack8(v + 8); }
            float mx = 0.f;
#pragma unroll
            for (int j = 0; j < 16; ++j) mx = fmaxf(mx, fabsf(v[j]));
            mx = wave_max(mx); const float scale = mx > 0.f ? mx * (1.f / 127.f) : 1.f, inv = 1.f / scale;
            u32x4 q; q.x = pack4q(v[0] * inv, v[1] * inv, v[2] * inv, v[3] * inv); q.y = pack4q(v[4] * inv, v[5] * inv, v[6] * inv, v[7] * inv); q.z = pack4q(v[8] * inv, v[9] * inv, v[10] * inv, v[11] * inv); q.w = pack4q(v[12] * inv, v[13] * inv, v[14] * inv, v[15] * inv);
            *(u32x4*)(ws + WS_XQ + row * D + lane * 16) = q; if (lane == 0) ((float*)(ws + WS_XSCALE))[row] = scale; }
        else { float* o = P.out + row * D + lane * 16; *(f32x4*)o = (f32x4){v[0], v[1], v[2], v[3]}; *(f32x4*)(o + 4) = (f32x4){v[4], v[5], v[6], v[7]};
               *(f32x4*)(o + 8) = (f32x4){v[8], v[9], v[10], v[11]}; *(f32x4*)(o + 12) = (f32x4){v[12], v[13], v[14], v[15]}; }
    }
}

__device__ __forceinline__ void conv_unit(const Ptrs& P, LAS unsigned char* lds, int unit, float vb) {
    const int tid = threadIdx.x, lane = tid & 63, wave = tid >> 6;
    unsigned char* wsc = fresh(P.ws); const unsigned char* Z = (const unsigned char*)(wsc + WS_Z); signed char* CATQ = (signed char*)(wsc + WS_CAT); LAS float* rowsc = (LAS float*)(lds + ROWSC_OFF);
    float w0[8], w1[8], w2[8];
#pragma unroll
    for (int j = 0; j < 8; ++j) { const float zz = 1.f / (Z_SCALE * Z_SCALE); w0[j] = P.conv_w[lane * 8 + j] * zz; w1[j] = P.conv_w[512 + lane * 8 + j] * zz; w2[j] = P.conv_w[1024 + lane * 8 + j] * zz; }
    const int t0 = unit * 128 + wave * 16;
    float hm2[8], hm1[8];
#pragma unroll
    for (int j = 0; j < 8; ++j) { hm2[j] = 0.f; hm1[j] = 0.f; }
    if ((t0 & (SEQ - 1)) != 0) {
        unpack_fp8x8(*(const u32x2*)(Z + (size_t)(t0 - 2) * 1536 + 512 + lane * 8), hm2);
        unpack_fp8x8(*(const u32x2*)(Z + (size_t)(t0 - 1) * 1536 + 512 + lane * 8), hm1);
    }
#pragma unroll 1
    for (int tb = t0; tb < t0 + 16; tb += 4) {
        u32x2 rb_[4], rh_[4];
#pragma unroll
        for (int k = 0; k < 4; ++k) { const unsigned char* zr = Z + (size_t)(tb + k) * 1536 + lane * 8; rb_[k] = *(const u32x2*)zr; rh_[k] = *(const u32x2*)(zr + 512); }
#pragma unroll
        for (int k = 0; k < 4; ++k) { float bgv[8], hv[8], o[8]; unpack_fp8x8(rb_[k], bgv); unpack_fp8x8(rh_[k], hv);
#pragma unroll
            for (int j = 0; j < 8; ++j) { const float h = hv[j]; o[j] = bgv[j] * (w0[j] * hm2[j] + w1[j] * hm1[j] + w2[j] * h); hm2[j] = hm1[j]; hm1[j] = h; }
            float mx = 0.f;
#pragma unroll
            for (int j = 0; j < 8; ++j) mx = fmaxf(mx, fabsf(o[j]));
            mx = fmaxf(wave_max(mx), vb); const float scale = mx > 0.f ? mx * (1.f / 127.f) : 1.f, inv = 1.f / scale;
            u32x2 q; q.x = pack4q(o[0] * inv, o[1] * inv, o[2] * inv, o[3] * inv); q.y = pack4q(o[4] * inv, o[5] * inv, o[6] * inv, o[7] * inv);
            *(u32x2*)(CATQ + (size_t)(tb + k) * D + lane * 8) = q;
            if (lane == 0) { ((float*)(wsc + WS_CSCALE))[tb + k] = scale; rowsc[(tb + k) & 255] = scale; } }
    }
}

namespace pg8 {
constexpr int BM = 256, BK = 64, HALF = 128, HTB = HALF * BK * 2, STAGE_BYTES = 8 * HTB, NXCD = 8, WGM = 8;
constexpr int META_OFF = STAGE_BYTES, META_SLOT = 3072;
constexpr int TAB_OFF = META_OFF + 3 * META_SLOT;
__host__ __device__ __forceinline__ int lds_byte(int r, int c) { const int st = (r >> 4) * 2 + (c >> 5), rr = r & 15, cc = c & 31, ob = rr * 64 + cc * 2; return st * 1024 + (ob ^ (((ob >> 9) & 1) << 5)); }
__host__ __device__ __forceinline__ void stage_rc(int b, int& R, int& C) { const int st = b / 1024, sb = b % 1024, swz = sb ^ (((sb >> 9) & 1) << 5); R = (st >> 1) * 16 + swz / 64; C = (st & 1) * 32 + (swz % 64) / 2; }
__host__ __device__ __forceinline__ int perm32(int rho) { const int n = rho >> 4, i = rho & 15; return 8 * (i >> 2) + 4 * n + (i & 3); }

struct Unit { int pm, pn; const char* A; const char* B; bf16* O; int ldc; int nvalid; const unsigned* meta; const float* rs; const float* cs; };

__device__ __forceinline__ bool static_tile(int i, int G, int c, int nM, int nN, int& pm, int& pn) {
    const int nwg = nM * nN; const long L = (long)i * G + c; if (L >= nwg) return false;
    int wgid = (int)L; { const int q = nwg / NXCD, r = nwg % NXCD, xcd = wgid % NXCD, off = wgid / NXCD; wgid = (xcd < r ? xcd * (q + 1) : r * (q + 1) + (xcd - r) * q) + off; }
    const int nig = WGM * nN, gid = wgid / nig, fm = gid * WGM, gsz = (nM - fm) < WGM ? (nM - fm) : WGM;
    pm = fm + ((wgid % nig) % gsz); pn = (wgid % nig) / gsz; return true;
}
struct SchedPlain {
    const char* A; const char* B; bf16* O; int nM, nN, pb, ldc, G, c; bf16* dummyO; const float* rs; const float* cs; bool panel;
    __device__ __forceinline__ bool next(int i, Unit& u) const { int pm, pn; if (panel) { if (i >= nN) return false; pm = c; pn = i; } else if (!static_tile(i, G, c, nM, nN, pm, pn)) return false;
        u.pm = pm; u.pn = pn; u.A = A + (size_t)pm * BM * pb; u.B = B + (size_t)pn * BM * pb; u.O = O; u.ldc = ldc; u.nvalid = 256; u.meta = nullptr; u.rs = rs + pm * BM; u.cs = cs + pn * BM;
        if (dummyO) { u.pm = c; u.pn = 0; u.O = dummyO; u.ldc = 256; } return true; }
};
struct SchedKV {
    const char* memb; const char* wk; const char* wv; bf16* kmat; bf16* vt; int G, c;
    __device__ __forceinline__ bool next(int i, Unit& u) const { const int L = i * G + c; if (L >= 128) return false; u.nvalid = 256; u.meta = nullptr; u.rs = nullptr; u.cs = nullptr;
        if (L < 64) { u.pm = L >> 2; u.pn = L & 3; u.A = memb + (size_t)u.pm * BM * 2048; u.B = wk + (size_t)u.pn * BM * 2048; u.O = kmat; u.ldc = 1024; }
        else { const int l2 = L - 64; u.pm = l2 >> 4; u.pn = l2 & 15; u.A = wv + (size_t)u.pm * BM * 2048; u.B = memb + (size_t)u.pn * BM * 2048; u.O = vt; u.ldc = 4096; }
        return true; }
};
struct SchedMoE {
    LAS unsigned char* lds; const char* A; const char* W; size_t wexp  ; int pb; bf16* O; int ldc; const unsigned* list; int NT, G, c; bool gatherA; const float* lscl; const float* csw  ;
    __device__ __forceinline__ bool next(int i, Unit& u) const { int pm, pn; if (!static_tile(i, G, c, NT, 4, pm, pn)) return false;
        const int lane = threadIdx.x & 63; const LAS int* tab = (const LAS int*)(lds + TAB_OFF);
        const int tsv = tab[lane & 15], cv = tab[16 + (lane & 15)];
        const unsigned long long m = __ballot(tsv <= pm) & 0xffffull; const int e = 63 - __builtin_clzll(m);
        const int ts = __builtin_amdgcn_readlane(tsv, e), ce = __builtin_amdgcn_readlane(cv, e); const int j = pm - ts; int nv = ce - 256 * j; nv = nv > 256 ? 256 : nv;
        u.pm = pm; u.pn = pn; u.nvalid = nv; u.meta = list + (size_t)e * T + 256 * j; u.O = O; u.ldc = ldc; u.rs = lscl + (size_t)e * T + 256 * j; u.cs = csw + e * 1024 + pn * BM;
        u.A = gatherA ? A : A + (size_t)pm * BM * pb; u.B = W + (size_t)e * wexp + (size_t)pn * BM * pb; return true; }
};
__device__ __forceinline__ int moe_tables(LAS unsigned char* lds, const unsigned* cnt) {
    const int lane = threadIdx.x & 63;
    const unsigned myc = __hip_atomic_load(cnt + 64 * (lane & 15), __ATOMIC_RELAXED, __HIP_MEMORY_SCOPE_AGENT);
    int start = 0; LAS int* tab = (LAS int*)(lds + TAB_OFF);
#pragma unroll
    for (int e = 0; e < 16; ++e) { const int ce = __builtin_amdgcn_readlane((int)myc, e); if (threadIdx.x == 0) { tab[e] = start; tab[16 + e] = ce; } start += (ce + 255) >> 8; }
    __syncthreads();
    return start;
}

__device__ __forceinline__ unsigned cvt_pk_bf16(float lo, float hi) { unsigned r; asm volatile("v_cvt_pk_bf16_f32 %0, %1, %2" : "=v"(r) : "v"(lo), "v"(hi)); return r; }
typedef float f32x2 __attribute__((ext_vector_type(2)));
__device__ __forceinline__ f32x2 gelu_pk(f32x2 v) {
    const f32x2 av = __builtin_elementwise_abs(v), d = av * 0.2316418882f + 1.0f;
    f32x2 t; t.x = __builtin_amdgcn_rcpf(d.x); t.y = __builtin_amdgcn_rcpf(d.y);
    f32x2 q = t * 0.5307027145f + (-0.7265760135f); q = q * t + 0.7107068705f; q = q * t + (-0.142248368f); q = q * t + 0.127414796f; q = q * t;
    const f32x2 s = (v * v) * (-0.72134752044f);
    f32x2 e; e.x = __builtin_amdgcn_exp2f(s.x); e.y = __builtin_amdgcn_exp2f(s.y);
    const f32x2 m = v * (q * e), r = v - m;
    f32x2 o; o.x = v.x < 0.f ? m.x : r.x; o.y = v.y < 0.f ? m.y : r.y; return o;
}
__device__ __forceinline__ unsigned ror8u(unsigned v) { return (unsigned)__builtin_amdgcn_update_dpp(0, (int)v, 0x128, 0xf, 0xf, false); }
__device__ __forceinline__ float ror8f(float v) { return __builtin_bit_cast(float, __builtin_amdgcn_update_dpp(0, __builtin_bit_cast(int, v), 0x128, 0xf, 0xf, false)); }
__device__ __forceinline__ void xchg_pk(const u32x4 P0, const u32x4 P1, bool lo, u32x4& S1, u32x4& S2) {
    u32x4 X, Y; X.x = lo ? P1.x : P0.x; X.y = lo ? P1.y : P0.y; X.z = lo ? P1.z : P0.z; X.w = lo ? P1.w : P0.w;
    Y.x = ror8u(X.x); Y.y = ror8u(X.y); Y.z = ror8u(X.z); Y.w = ror8u(X.w);
    S1.x = lo ? P0.x : Y.x; S1.y = lo ? P0.y : Y.y; S1.z = lo ? P0.z : Y.z; S1.w = lo ? P0.w : Y.w;
    S2.x = lo ? Y.x : P1.x; S2.y = lo ? Y.y : P1.y; S2.z = lo ? Y.z : P1.z; S2.w = lo ? Y.w : P1.w;
}
__device__ __forceinline__ u32x4 lane_gather(const u32x4 v, int idx4) { u32x4 r; r.x = (unsigned)__builtin_amdgcn_ds_bpermute(idx4, (int)v.x); r.y = (unsigned)__builtin_amdgcn_ds_bpermute(idx4, (int)v.y);
    r.z = (unsigned)__builtin_amdgcn_ds_bpermute(idx4, (int)v.z); r.w = (unsigned)__builtin_amdgcn_ds_bpermute(idx4, (int)v.w); return r; }
struct EpiStore {
    static constexpr int PERM = 2; int gelu_tiles; int skip; unsigned* vbound;
    __device__ __forceinline__ void operator()(const f32x4 (&acc)[2][2][4][2], const Unit& u, int wr, int wc, int fr, int fq, LAS unsigned char*, int) const {
        if (skip == 1) return;
        if (vbound && u.ldc == 4096) { float mx = 0.f;
#pragma unroll
            for (int ai = 0; ai < 2; ++ai)
#pragma unroll
                for (int bj = 0; bj < 2; ++bj)
#pragma unroll
                    for (int m = 0; m < 4; ++m)
#pragma unroll
                        for (int n = 0; n < 2; ++n) { const f32x4 v = acc[ai][bj][m][n]; mx = fmaxf(fmaxf(mx, fmaxf(fabsf(v[0]), fabsf(v[1]))), fmaxf(fabsf(v[2]), fabsf(v[3]))); }
            mx = wave_max(mx); if (fr == 0 && fq == 0) atomicMax(vbound + (u.pm >> 1) * 16 + u.pn, __builtin_bit_cast(unsigned, mx * 1.01f)); }
        const bool lo = fr < 8; const bool act = u.pn < gelu_tiles; const int lane = fq * 16 + fr;
        const int idx4 = 4 * ((lane & 3) * 16 + (lane >> 3) + 8 * ((lane >> 2) & 1));
        const int row0 = u.pm * BM + wr * 64 + (lane >> 3), col0 = u.pn * BM + wc * 64 + 8 * (lane & 7);
#pragma unroll
        for (int ai = 0; ai < 2; ++ai)
#pragma unroll
            for (int m = 0; m < 4; ++m) { u32x4 Pk[2];
#pragma unroll
                for (int bj = 0; bj < 2; ++bj) { f32x4 v0 = acc[ai][bj][m][0], v1 = acc[ai][bj][m][1];
                    if (act) { f32x2 a = gelu_pk((f32x2){v0[0], v0[1]}), b = gelu_pk((f32x2){v0[2], v0[3]}), c = gelu_pk((f32x2){v1[0], v1[1]}), d = gelu_pk((f32x2){v1[2], v1[3]});
                        v0 = (f32x4){a.x, a.y, b.x, b.y}; v1 = (f32x4){c.x, c.y, d.x, d.y}; }
                    Pk[bj].x = cvt_pk_bf16(v0[0], v0[1]); Pk[bj].y = cvt_pk_bf16(v0[2], v0[3]); Pk[bj].z = cvt_pk_bf16(v1[0], v1[1]); Pk[bj].w = cvt_pk_bf16(v1[2], v1[3]); }
                u32x4 S1, S2; xchg_pk(Pk[0], Pk[1], lo, S1, S2); S1 = lane_gather(S1, idx4); S2 = lane_gather(S2, idx4);
                bf16* rowp = u.O + (size_t)(row0 + ai * HALF + m * 16) * u.ldc + col0;
                if (skip == 4) { const int wv = wr * 4 + wc, t0 = (ai * 4 + m) * 2; bf16* q0 = u.O + (size_t)(u.pm * BM + 2 * (t0 * 8 + wv) + (lane >> 5)) * u.ldc + u.pn * BM + 8 * (lane & 31);
                    *(u32x4*)q0 = S1; *(u32x4*)(q0 + (size_t)16 * u.ldc) = S2; }
                else { *(u32x4*)rowp = S1; *(u32x4*)(rowp + (size_t)8 * u.ldc) = S2; } }
    }
};
struct EpiStoreI8 {
    static constexpr int PERM = 2; int gelu_tiles, mul_lo, mul_hi;
    __device__ __forceinline__ void operator()(const i32x4 (&acc)[2][2][4][2], const Unit& u, int wr, int wc, int fr, int fq, LAS unsigned char* lds, int slot) const {
        const bool lo = fr < 8; const bool act = u.pn < gelu_tiles; const int lane = fq * 16 + fr;
        const int idx4 = 4 * ((lane & 3) * 16 + (lane >> 3) + 8 * ((lane >> 2) & 1));
        const bool mul = u.pn >= mul_lo && u.pn < mul_hi;
        const int colbase = u.pn < mul_lo ? u.pn * BM : (mul ? mul_lo * BM + (u.pn - mul_lo) * HALF : mul_lo * BM + (mul_hi - mul_lo) * HALF + (u.pn - mul_hi) * BM);
        const LAS float* rsl = (const LAS float*)(lds + META_OFF + slot * META_SLOT + 1024); const LAS float* csl = (const LAS float*)(lds + META_OFF + slot * META_SLOT + 2048);
        f32x4 cv[2][2];
#pragma unroll
        for (int bj = 0; bj < 2; ++bj)
#pragma unroll
            for (int n = 0; n < 2; ++n) cv[bj][n] = *(const LAS f32x4*)(csl + wc * 64 + 32 * bj + 8 * fq + 4 * n);
        if (mul) {
            const int prow0 = u.pm * BM + wr * 64 + fr, pcol0 = colbase + wc * 32 + 8 * fq;
#pragma unroll
            for (int ai = 0; ai < 2; ++ai)
#pragma unroll
                for (int m = 0; m < 4; ++m) { const float rsv = rsl[ai * HALF + wr * 64 + m * 16 + fr]; float hv[8];
#pragma unroll
                    for (int k = 0; k < 8; ++k) hv[k] = ((float)acc[ai][0][m][k >> 2][k & 3] * (rsv * cv[0][k >> 2][k & 3])) * ((float)acc[ai][1][m][k >> 2][k & 3] * (rsv * cv[1][k >> 2][k & 3]));
                    u32x4 w; w.x = cvt_pk_bf16(hv[0], hv[1]); w.y = cvt_pk_bf16(hv[2], hv[3]); w.z = cvt_pk_bf16(hv[4], hv[5]); w.w = cvt_pk_bf16(hv[6], hv[7]);
                    *(u32x4*)(u.O + (size_t)(prow0 + ai * HALF + m * 16) * u.ldc + pcol0) = w; }
            return; }
        const int row0 = u.pm * BM + wr * 64 + (lane >> 3), col0 = colbase + wc * 64 + 8 * (lane & 7);
#pragma unroll
        for (int ai = 0; ai < 2; ++ai)
#pragma unroll
            for (int m = 0; m < 4; ++m) { u32x4 Pk[2]; const float rsv = rsl[ai * HALF + wr * 64 + m * 16 + fr];
#pragma unroll
                for (int bj = 0; bj < 2; ++bj) { f32x4 v0, v1;
#pragma unroll
                    for (int k = 0; k < 4; ++k) { v0[k] = (float)acc[ai][bj][m][0][k] * (rsv * cv[bj][0][k]); v1[k] = (float)acc[ai][bj][m][1][k] * (rsv * cv[bj][1][k]); }
                    if (act) { f32x2 a = gelu_pk((f32x2){v0[0], v0[1]}), b = gelu_pk((f32x2){v0[2], v0[3]}), c = gelu_pk((f32x2){v1[0], v1[1]}), d = gelu_pk((f32x2){v1[2], v1[3]});
                        v0 = (f32x4){a.x, a.y, b.x, b.y}; v1 = (f32x4){c.x, c.y, d.x, d.y}; }
                    Pk[bj].x = cvt_pk_bf16(v0[0], v0[1]); Pk[bj].y = cvt_pk_bf16(v0[2], v0[3]); Pk[bj].z = cvt_pk_bf16(v1[0], v1[1]); Pk[bj].w = cvt_pk_bf16(v1[2], v1[3]); }
                u32x4 S1, S2; xchg_pk(Pk[0], Pk[1], lo, S1, S2); S1 = lane_gather(S1, idx4); S2 = lane_gather(S2, idx4);
                bf16* rowp = u.O + (size_t)(row0 + ai * HALF + m * 16) * u.ldc + col0;
                *(u32x4*)rowp = S1; *(u32x4*)(rowp + (size_t)8 * u.ldc) = S2; }
    }
};
struct EpiResidI8 {
    static constexpr int PERM = 2; const bf16* R;
    __device__ __forceinline__ void operator()(const i32x4 (&acc)[2][2][4][2], const Unit& u, int wr, int wc, int fr, int fq, LAS unsigned char* lds, int slot) const {
        const bool lo = fr < 8; const int lane = fq * 16 + fr;
        const int idx4 = 4 * ((lane & 3) * 16 + (lane >> 3) + 8 * ((lane >> 2) & 1));
        const int row0 = u.pm * BM + wr * 64 + (lane >> 3), col0 = u.pn * BM + wc * 64 + 8 * (lane & 7);
        const LAS float* rsl = (const LAS float*)(lds + META_OFF + slot * META_SLOT + 1024); const LAS float* csl = (const LAS float*)(lds + META_OFF + slot * META_SLOT + 2048);
        f32x4 cv[2][2];
#pragma unroll
        for (int bj = 0; bj < 2; ++bj)
#pragma unroll
            for (int n = 0; n < 2; ++n) cv[bj][n] = *(const LAS f32x4*)(csl + wc * 64 + 32 * bj + 8 * fq + 4 * n);
#pragma unroll
        for (int ai = 0; ai < 2; ++ai) { u32x4 rr[4][2];
#pragma unroll
            for (int m = 0; m < 4; ++m) { const size_t off = (size_t)(row0 + ai * HALF + m * 16) * u.ldc + col0; rr[m][0] = *(const u32x4*)(R + off); rr[m][1] = *(const u32x4*)(R + off + (size_t)8 * u.ldc); }
#pragma unroll
            for (int m = 0; m < 4; ++m) { u32x4 Pk[2]; const float rsv = rsl[ai * HALF + wr * 64 + m * 16 + fr];
#pragma unroll
                for (int bj = 0; bj < 2; ++bj) { float v[8];
#pragma unroll
                    for (int k = 0; k < 8; ++k) v[k] = (float)acc[ai][bj][m][k >> 2][k & 3] * (rsv * cv[bj][k >> 2][k & 3]);
                    Pk[bj].x = cvt_pk_bf16(v[0], v[1]); Pk[bj].y = cvt_pk_bf16(v[2], v[3]); Pk[bj].z = cvt_pk_bf16(v[4], v[5]); Pk[bj].w = cvt_pk_bf16(v[6], v[7]); }
                u32x4 S1, S2; xchg_pk(Pk[0], Pk[1], lo, S1, S2); S1 = lane_gather(S1, idx4); S2 = lane_gather(S2, idx4);
                const u32x4 r1 = rr[m][0], r2 = rr[m][1]; u32x4 w1, w2;
                w1.x = cvt_pk_bf16(bflo(S1.x) + ALPHA * bflo(r1.x), bfhi(S1.x) + ALPHA * bfhi(r1.x)); w1.y = cvt_pk_bf16(bflo(S1.y) + ALPHA * bflo(r1.y), bfhi(S1.y) + ALPHA * bfhi(r1.y));
                w1.z = cvt_pk_bf16(bflo(S1.z) + ALPHA * bflo(r1.z), bfhi(S1.z) + ALPHA * bfhi(r1.z)); w1.w = cvt_pk_bf16(bflo(S1.w) + ALPHA * bflo(r1.w), bfhi(S1.w) + ALPHA * bfhi(r1.w));
                w2.x = cvt_pk_bf16(bflo(S2.x) + ALPHA * bflo(r2.x), bfhi(S2.x) + ALPHA * bfhi(r2.x)); w2.y = cvt_pk_bf16(bflo(S2.y) + ALPHA * bflo(r2.y), bfhi(S2.y) + ALPHA * bfhi(r2.y));
                w2.z = cvt_pk_bf16(bflo(S2.z) + ALPHA * bflo(r2.z), bfhi(S2.z) + ALPHA * bfhi(r2.z)); w2.w = cvt_pk_bf16(bflo(S2.w) + ALPHA * bflo(r2.w), bfhi(S2.w) + ALPHA * bfhi(r2.w));
                bf16* rowp = u.O + (size_t)(row0 + ai * HALF + m * 16) * u.ldc + col0;
                *(u32x4*)rowp = w1; *(u32x4*)(rowp + (size_t)8 * u.ldc) = w2; } }
    }
};
struct EpiResidQ8 {
    static constexpr int PERM = 2; const unsigned char* RQ; const float* RS;
    __device__ __forceinline__ void operator()(const i32x4 (&acc)[2][2][4][2], const Unit& u, int wr, int wc, int fr, int fq, LAS unsigned char* lds, int slot) const {
        const bool lo = fr < 8; const int lane = fq * 16 + fr;
        const int idx4 = 4 * ((lane & 3) * 16 + (lane >> 3) + 8 * ((lane >> 2) & 1));
        const int row0 = u.pm * BM + wr * 64 + (lane >> 3), col0 = u.pn * BM + wc * 64 + 8 * (lane & 7);
        const LAS float* rsl = (const LAS float*)(lds + META_OFF + slot * META_SLOT + 1024); const LAS float* csl = (const LAS float*)(lds + META_OFF + slot * META_SLOT + 2048);
        f32x4 cv[2][2];
#pragma unroll
        for (int bj = 0; bj < 2; ++bj)
#pragma unroll
            for (int n = 0; n < 2; ++n) cv[bj][n] = *(const LAS f32x4*)(csl + wc * 64 + 32 * bj + 8 * fq + 4 * n);
#pragma unroll
        for (int ai = 0; ai < 2; ++ai) { u32x2 rq[4][2]; float rsc[4][2];
#pragma unroll
            for (int m = 0; m < 4; ++m) { const size_t r1 = (size_t)(row0 + ai * HALF + m * 16); rq[m][0] = *(const u32x2*)(RQ + r1 * 1024 + col0); rq[m][1] = *(const u32x2*)(RQ + (r1 + 8) * 1024 + col0); rsc[m][0] = RS[r1]; rsc[m][1] = RS[r1 + 8]; }
#pragma unroll
            for (int m = 0; m < 4; ++m) { u32x4 Pk[2]; const float rsv = rsl[ai * HALF + wr * 64 + m * 16 + fr];
#pragma unroll
                for (int bj = 0; bj < 2; ++bj) { float v[8];
#pragma unroll
                    for (int k = 0; k < 8; ++k) v[k] = (float)acc[ai][bj][m][k >> 2][k & 3] * (rsv * cv[bj][k >> 2][k & 3]);
                    Pk[bj].x = cvt_pk_bf16(v[0], v[1]); Pk[bj].y = cvt_pk_bf16(v[2], v[3]); Pk[bj].z = cvt_pk_bf16(v[4], v[5]); Pk[bj].w = cvt_pk_bf16(v[6], v[7]); }
                u32x4 S1, S2; xchg_pk(Pk[0], Pk[1], lo, S1, S2); S1 = lane_gather(S1, idx4); S2 = lane_gather(S2, idx4);
                u32x4 w[2];
#pragma unroll
                for (int hh = 0; hh < 2; ++hh) { const u32x4 Sx = hh == 0 ? S1 : S2; const float as = ALPHA * rsc[m][hh], ao = -128.f * as;
                    const unsigned q0 = rq[m][hh].x ^ 0x80808080u, q1 = rq[m][hh].y ^ 0x80808080u;
                    w[hh].x = cvt_pk_bf16(bflo(Sx.x) + ((float)(q0 & 255u) * as + ao), bfhi(Sx.x) + ((float)((q0 >> 8) & 255u) * as + ao)); w[hh].y = cvt_pk_bf16(bflo(Sx.y) + ((float)((q0 >> 16) & 255u) * as + ao), bfhi(Sx.y) + ((float)(q0 >> 24) * as + ao));
                    w[hh].z = cvt_pk_bf16(bflo(Sx.z) + ((float)(q1 & 255u) * as + ao), bfhi(Sx.z) + ((float)((q1 >> 8) & 255u) * as + ao)); w[hh].w = cvt_pk_bf16(bflo(Sx.w) + ((float)((q1 >> 16) & 255u) * as + ao), bfhi(Sx.w) + ((float)(q1 >> 24) * as + ao)); }
                bf16* rowp = u.O + (size_t)(row0 + ai * HALF + m * 16) * u.ldc + col0;
                *(u32x4*)rowp = w[0]; *(u32x4*)(rowp + (size_t)8 * u.ldc) = w[1]; } }
    }
};
struct EpiResid {
    static constexpr int PERM = 2; const bf16* R;
    __device__ __forceinline__ void operator()(const f32x4 (&acc)[2][2][4][2], const Unit& u, int wr, int wc, int fr, int fq, LAS unsigned char*, int) const {
        const bool lo = fr < 8;
        const int row0 = u.pm * BM + wr * 64 + (fr & 7), col0 = u.pn * BM + wc * 64 + (lo ? 0 : 32) + 8 * fq;
        u32x4 rr[2][4][2];
#pragma unroll
        for (int ai = 0; ai < 2; ++ai)
#pragma unroll
            for (int m = 0; m < 4; ++m) { const size_t off = (size_t)(row0 + ai * HALF + m * 16) * u.ldc + col0; rr[ai][m][0] = *(const u32x4*)(R + off); rr[ai][m][1] = *(const u32x4*)(R + off + (size_t)8 * u.ldc); }
#pragma unroll
        for (int ai = 0; ai < 2; ++ai)
#pragma unroll
            for (int m = 0; m < 4; ++m) { const size_t off = (size_t)(row0 + ai * HALF + m * 16) * u.ldc + col0;
                float s1[8], s2[8];
#pragma unroll
                for (int k = 0; k < 8; ++k) { const float a = acc[ai][0][m][k >> 2][k & 3], b = acc[ai][1][m][k >> 2][k & 3]; const float y = ror8f(lo ? b : a); s1[k] = lo ? a : y; s2[k] = lo ? y : b; }
                const u32x4 r1 = rr[ai][m][0], r2 = rr[ai][m][1];
                u32x4 w1, w2;
                w1.x = cvt_pk_bf16(s1[0] + ALPHA * bflo(r1.x), s1[1] + ALPHA * bfhi(r1.x)); w1.y = cvt_pk_bf16(s1[2] + ALPHA * bflo(r1.y), s1[3] + ALPHA * bfhi(r1.y));
                w1.z = cvt_pk_bf16(s1[4] + ALPHA * bflo(r1.z), s1[5] + ALPHA * bfhi(r1.z)); w1.w = cvt_pk_bf16(s1[6] + ALPHA * bflo(r1.w), s1[7] + ALPHA * bfhi(r1.w));
                w2.x = cvt_pk_bf16(s2[0] + ALPHA * bflo(r2.x), s2[1] + ALPHA * bfhi(r2.x)); w2.y = cvt_pk_bf16(s2[2] + ALPHA * bflo(r2.y), s2[3] + ALPHA * bfhi(r2.y));
                w2.z = cvt_pk_bf16(s2[4] + ALPHA * bflo(r2.z), s2[5] + ALPHA * bfhi(r2.z)); w2.w = cvt_pk_bf16(s2[6] + ALPHA * bflo(r2.w), s2[7] + ALPHA * bfhi(r2.w));
                *(u32x4*)(u.O + off) = w1; *(u32x4*)(u.O + off + (size_t)8 * u.ldc) = w2; }
    }
};
__device__ __forceinline__ float silu_mul(float g, float uu) { return g * __builtin_amdgcn_rcpf(1.f + __builtin_amdgcn_exp2f(-1.44269504089f * g)) * uu; }
struct EpiSwiGLU {
    static constexpr int PERM = 1;
    __device__ __forceinline__ void operator()(const f32x4 (&acc)[2][2][4][2], const Unit& u, int wr, int wc, int fr, int fq, LAS unsigned char*, int) const {
        const int row0 = u.pm * BM + wr * 64 + fr, col0 = u.pn * HALF + wc * 32 + 8 * fq;
#pragma unroll
        for (int ai = 0; ai < 2; ++ai)
#pragma unroll
            for (int m = 0; m < 4; ++m) { const f32x4 g0 = acc[ai][0][m][0], g1 = acc[ai][0][m][1], u0 = acc[ai][1][m][0], u1 = acc[ai][1][m][1];
                u32x4 w; w.x = cvt_pk_bf16(silu_mul(g0[0], u0[0]), silu_mul(g0[1], u0[1])); w.y = cvt_pk_bf16(silu_mul(g0[2], u0[2]), silu_mul(g0[3], u0[3]));
                w.z = cvt_pk_bf16(silu_mul(g1[0], u1[0]), silu_mul(g1[1], u1[1])); w.w = cvt_pk_bf16(silu_mul(g1[2], u1[2]), silu_mul(g1[3], u1[3]));
                *(u32x4*)(u.O + (size_t)(row0 + ai * HALF + m * 16) * u.ldc + col0) = w; }
    }
};
__device__ __forceinline__ unsigned pk4_fp8(float a, float b, float c, float d) { int r = __builtin_amdgcn_cvt_pk_fp8_f32(a, b, 0, false); r = __builtin_amdgcn_cvt_pk_fp8_f32(c, d, r, true); return (unsigned)r; }
struct EpiSwiGLUI8 {
    static constexpr int PERM = 1;
    __device__ __forceinline__ void operator()(const i32x4 (&acc)[2][2][4][2], const Unit& u, int wr, int wc, int fr, int fq, LAS unsigned char* lds, int slot) const {
        const int row0 = u.pm * BM + wr * 64 + fr, col0 = u.pn * HALF + wc * 32 + 8 * fq;
        const LAS float* rsl = (const LAS float*)(lds + META_OFF + slot * META_SLOT + 1024); const LAS float* csl = (const LAS float*)(lds + META_OFF + slot * META_SLOT + 2048);
        f32x4 cg[2], cu[2];
#pragma unroll
        for (int n = 0; n < 2; ++n) { cg[n] = *(const LAS f32x4*)(csl + wc * 32 + 8 * fq + 4 * n); cu[n] = *(const LAS f32x4*)(csl + HALF + wc * 32 + 8 * fq + 4 * n) * H_SCALE; }
        unsigned char* HQ = (unsigned char*)u.O;
#pragma unroll
        for (int ai = 0; ai < 2; ++ai)
#pragma unroll
            for (int m = 0; m < 4; ++m) { const int r = ai * HALF + wr * 64 + m * 16 + fr; const float rsv = r < u.nvalid ? rsl[r] : 0.f; float hv[8];
                const f32x2 rs2 = (f32x2){rsv, rsv};
#pragma unroll
                for (int j = 0; j < 4; ++j) { const int k = 2 * j;
                    const f32x2 ag = (f32x2){(float)acc[ai][0][m][k >> 2][k & 3], (float)acc[ai][0][m][k >> 2][(k & 3) + 1]}, au = (f32x2){(float)acc[ai][1][m][k >> 2][k & 3], (float)acc[ai][1][m][k >> 2][(k & 3) + 1]};
                    const f32x2 tg = ag * (rs2 * (f32x2){cg[k >> 2][k & 3], cg[k >> 2][(k & 3) + 1]}), hu = au * (rs2 * (f32x2){cu[k >> 2][k & 3], cu[k >> 2][(k & 3) + 1]}), tn = tg * (-1.44269504089f);
                    f32x2 e; e.x = __builtin_amdgcn_exp2f(tn.x); e.y = __builtin_amdgcn_exp2f(tn.y);
                    const f32x2 d = e + 1.f; f32x2 rr; rr.x = __builtin_amdgcn_rcpf(d.x); rr.y = __builtin_amdgcn_rcpf(d.y);
                    const f32x2 hh = (tg * rr) * hu;
                    hv[k] = __builtin_amdgcn_fmed3f(hh.x, -448.f, 448.f); hv[k + 1] = __builtin_amdgcn_fmed3f(hh.y, -448.f, 448.f); }
                u32x2 w; w.x = pk4_fp8(hv[0], hv[1], hv[2], hv[3]); w.y = pk4_fp8(hv[4], hv[5], hv[6], hv[7]);
                *(u32x2*)(HQ + (size_t)(row0 + ai * HALF + m * 16) * 512 + col0) = w; }
    }
};
struct EpiScatter {
    static constexpr int PERM = 2;
    __device__ __forceinline__ void operator()(const f32x4 (&acc)[2][2][4][2], const Unit& u, int wr, int wc, int fr, int fq, LAS unsigned char* lds, int slot) const {
        const LAS unsigned* ent = (const LAS unsigned*)(lds + META_OFF + slot * META_SLOT); const bool lo = fr < 8; const int lane = fq * 16 + fr;
        const int idx4 = 4 * ((lane & 3) * 16 + (lane >> 3) + 8 * ((lane >> 2) & 1));
        const int col0 = u.pn * BM + wc * 64 + 8 * (lane & 7);
        unsigned char* Y8 = (unsigned char*)u.O;
#pragma unroll
        for (int ai = 0; ai < 2; ++ai)
#pragma unroll
            for (int m = 0; m < 4; ++m) { u32x2 Pk[2];
#pragma unroll
                for (int bj = 0; bj < 2; ++bj) { const f32x4 v0 = acc[ai][bj][m][0] * Y_SCALE, v1 = acc[ai][bj][m][1] * Y_SCALE; Pk[bj].x = pk4_fp8(v0[0], v0[1], v0[2], v0[3]); Pk[bj].y = pk4_fp8(v1[0], v1[1], v1[2], v1[3]); }
                u32x2 X, Yv, S1, S2; X.x = lo ? Pk[1].x : Pk[0].x; X.y = lo ? Pk[1].y : Pk[0].y; Yv.x = ror8u(X.x); Yv.y = ror8u(X.y);
                S1.x = lo ? Pk[0].x : Yv.x; S1.y = lo ? Pk[0].y : Yv.y; S2.x = lo ? Yv.x : Pk[1].x; S2.y = lo ? Yv.y : Pk[1].y;
                S1.x = (unsigned)__builtin_amdgcn_ds_bpermute(idx4, (int)S1.x); S1.y = (unsigned)__builtin_amdgcn_ds_bpermute(idx4, (int)S1.y); S2.x = (unsigned)__builtin_amdgcn_ds_bpermute(idx4, (int)S2.x); S2.y = (unsigned)__builtin_amdgcn_ds_bpermute(idx4, (int)S2.y);
                const int r1 = ai * HALF + wr * 64 + m * 16 + (lane >> 3), r2 = r1 + 8;
                if (r1 < u.nvalid) *(u32x2*)(Y8 + (size_t)ent[r1] * 1024 + col0) = S1;
                if (r2 < u.nvalid) *(u32x2*)(Y8 + (size_t)ent[r2] * 1024 + col0) = S2; }
    }
};

struct EpiStoreF8z {
    static constexpr int PERM = 2; int gelu_tiles, mul_lo, mul_hi;
    __device__ __forceinline__ void operator()(const i32x4 (&acc)[2][2][4][2], const Unit& u, int wr, int wc, int fr_in, int fq_in, LAS unsigned char* lds, int slot) const {
        (void)fr_in; (void)fq_in; int lane; asm volatile("v_mbcnt_lo_u32_b32 %0, -1, 0\n\tv_mbcnt_hi_u32_b32 %0, -1, %0" : "=v"(lane));
        const int fr = lane & 15, fq = lane >> 4;
        const bool lo = fr < 8; const bool act = u.pn < gelu_tiles;
        const int idx4 = 4 * ((lane & 3) * 16 + (lane >> 3) + 8 * ((lane >> 2) & 1));
        const bool mul = u.pn >= mul_lo && u.pn < mul_hi;
        const int colbase = u.pn < mul_lo ? u.pn * BM : (mul ? mul_lo * BM + (u.pn - mul_lo) * HALF : mul_lo * BM + (mul_hi - mul_lo) * HALF + (u.pn - mul_hi) * BM);
        const LAS float* rsl = (const LAS float*)(lds + META_OFF + slot * META_SLOT + 1024); const LAS float* csl = (const LAS float*)(lds + META_OFF + slot * META_SLOT + 2048);
        unsigned char* Z8 = (unsigned char*)u.O;
        f32x4 cv[2][2];
#pragma unroll
        for (int bj = 0; bj < 2; ++bj)
#pragma unroll
            for (int n = 0; n < 2; ++n) cv[bj][n] = *(const LAS f32x4*)(csl + wc * 64 + 32 * bj + 8 * fq + 4 * n);
        if (mul) {
            const int prow0 = u.pm * BM + wr * 64 + fr, pcol0 = colbase + wc * 32 + 8 * fq;
#pragma unroll
            for (int ai = 0; ai < 2; ++ai)
#pragma unroll
                for (int m = 0; m < 4; ++m) { const float rsv = rsl[ai * HALF + wr * 64 + m * 16 + fr], rsz = rsv * Z_SCALE; float hv[8];
#pragma unroll
                    for (int k = 0; k < 8; ++k) hv[k] = __builtin_amdgcn_fmed3f(((float)acc[ai][0][m][k >> 2][k & 3] * (rsz * cv[0][k >> 2][k & 3])) * ((float)acc[ai][1][m][k >> 2][k & 3] * (rsv * cv[1][k >> 2][k & 3])), -448.f, 448.f);
                    u32x2 w; w.x = pk4_fp8(hv[0], hv[1], hv[2], hv[3]); w.y = pk4_fp8(hv[4], hv[5], hv[6], hv[7]);
                    *(u32x2*)(Z8 + (size_t)(prow0 + ai * HALF + m * 16) * u.ldc + pcol0) = w; }
            return; }
        const int row0 = u.pm * BM + wr * 64 + (lane >> 3), col0 = colbase + wc * 64 + 8 * (lane & 7);
        const float zs = act ? 1.f : Z_SCALE, za = act ? Z_SCALE : 1.f;
#pragma unroll
        for (int ai = 0; ai < 2; ++ai)
#pragma unroll
            for (int m = 0; m < 4; ++m) { u32x2 Pk[2]; const float rsv = rsl[ai * HALF + wr * 64 + m * 16 + fr] * zs;
#pragma unroll
                for (int bj = 0; bj < 2; ++bj) { f32x4 v0, v1;
#pragma unroll
                    for (int k = 0; k < 4; ++k) { v0[k] = (float)acc[ai][bj][m][0][k] * (rsv * cv[bj][0][k]); v1[k] = (float)acc[ai][bj][m][1][k] * (rsv * cv[bj][1][k]); }
                    if (act) { f32x2 a = gelu_pk((f32x2){v0[0], v0[1]}) * za, b = gelu_pk((f32x2){v0[2], v0[3]}) * za, c = gelu_pk((f32x2){v1[0], v1[1]}) * za, d = gelu_pk((f32x2){v1[2], v1[3]}) * za;
                        v0 = (f32x4){a.x, a.y, b.x, b.y}; v1 = (f32x4){c.x, c.y, d.x, d.y}; }
                    Pk[bj].x = pk4_fp8(v0[0], v0[1], v0[2], v0[3]); Pk[bj].y = pk4_fp8(v1[0], v1[1], v1[2], v1[3]); }
                u32x2 X, Yv, S1, S2; X.x = lo ? Pk[1].x : Pk[0].x; X.y = lo ? Pk[1].y : Pk[0].y; Yv.x = ror8u(X.x); Yv.y = ror8u(X.y);
                S1.x = lo ? Pk[0].x : Yv.x; S1.y = lo ? Pk[0].y : Yv.y; S2.x = lo ? Yv.x : Pk[1].x; S2.y = lo ? Yv.y : Pk[1].y;
                S1.x = (unsigned)__builtin_amdgcn_ds_bpermute(idx4, (int)S1.x); S1.y = (unsigned)__builtin_amdgcn_ds_bpermute(idx4, (int)S1.y); S2.x = (unsigned)__builtin_amdgcn_ds_bpermute(idx4, (int)S2.x); S2.y = (unsigned)__builtin_amdgcn_ds_bpermute(idx4, (int)S2.y);
                unsigned char* rowp = Z8 + (size_t)(row0 + ai * HALF + m * 16) * u.ldc + col0;
                *(u32x2*)rowp = S1; *(u32x2*)(rowp + (size_t)8 * u.ldc) = S2; }
    }
};
struct EpiScatterF8 {
    static constexpr int PERM = 2;
    __device__ __forceinline__ void operator()(const f32x4 (&acc)[2][2][4][2], const Unit& u, int wr, int wc, int fr_in, int fq_in, LAS unsigned char* lds, int slot) const {
        (void)fr_in; (void)fq_in; int lane; asm volatile("v_mbcnt_lo_u32_b32 %0, -1, 0\n\tv_mbcnt_hi_u32_b32 %0, -1, %0" : "=v"(lane));
        const int fr = lane & 15, fq = lane >> 4;
        const LAS unsigned* ent = (const LAS unsigned*)(lds + META_OFF + slot * META_SLOT); const bool lo = fr < 8;
        const LAS float* csl = (const LAS float*)(lds + META_OFF + slot * META_SLOT + 2048);
        const int idx4 = 4 * ((lane & 3) * 16 + (lane >> 3) + 8 * ((lane >> 2) & 1));
        const int col0 = u.pn * BM + wc * 64 + 8 * (lane & 7);
        unsigned char* Y8 = (unsigned char*)u.O;
#pragma unroll
        for (int ai = 0; ai < 2; ++ai)
#pragma unroll
            for (int m = 0; m < 4; ++m) { u32x2 Pk[2];
#pragma unroll
                for (int bj = 0; bj < 2; ++bj) { const f32x4 c0 = *(const LAS f32x4*)(csl + wc * 64 + 32 * bj + 8 * fq), c1 = *(const LAS f32x4*)(csl + wc * 64 + 32 * bj + 8 * fq + 4);
                    const f32x4 v0 = acc[ai][bj][m][0] * (c0 * (Y_SCALE / H_SCALE)), v1 = acc[ai][bj][m][1] * (c1 * (Y_SCALE / H_SCALE)); Pk[bj].x = pk4_fp8(v0[0], v0[1], v0[2], v0[3]); Pk[bj].y = pk4_fp8(v1[0], v1[1], v1[2], v1[3]); }
                u32x2 X, Yv, S1, S2; X.x = lo ? Pk[1].x : Pk[0].x; X.y = lo ? Pk[1].y : Pk[0].y; Yv.x = ror8u(X.x); Yv.y = ror8u(X.y);
                S1.x = lo ? Pk[0].x : Yv.x; S1.y = lo ? Pk[0].y : Yv.y; S2.x = lo ? Yv.x : Pk[1].x; S2.y = lo ? Yv.y : Pk[1].y;
                S1.x = (unsigned)__builtin_amdgcn_ds_bpermute(idx4, (int)S1.x); S1.y = (unsigned)__builtin_amdgcn_ds_bpermute(idx4, (int)S1.y); S2.x = (unsigned)__builtin_amdgcn_ds_bpermute(idx4, (int)S2.x); S2.y = (unsigned)__builtin_amdgcn_ds_bpermute(idx4, (int)S2.y);
                const int r1 = ai * HALF + wr * 64 + m * 16 + (lane >> 3), r2 = r1 + 8;
                if (r1 < u.nvalid) *(u32x2*)(Y8 + (size_t)ent[r1] * 1024 + col0) = S1;
                if (r2 < u.nvalid) *(u32x2*)(Y8 + (size_t)ent[r2] * 1024 + col0) = S2; }
    }
};

template <class Epi, class Sched, bool GATHER, bool META, int KIND = 0, bool SCALES = false>
__device__ __forceinline__ void gemm_phase(LAS unsigned char* lds, const int PB, const Sched& S, const Epi& E) {
    int tid_ = threadIdx.x; asm volatile("" : "+v"(tid_));
    const int tid = tid_, wid = __builtin_amdgcn_readfirstlane(tid >> 6), lane = tid & 63, wr = wid >> 2, wc = wid & 3, fr = lane & 15, fq = lane >> 4;
    const int nt = PB / 128;
    unsigned voffA[2][2], nvoffA[2][2], voffB[2];
    const size_t hstep = (size_t)HALF * PB;
#pragma unroll
    for (int i = 0; i < 2; ++i) { int R, C; stage_rc(tid * 16 + i * 8192, R, C);
        voffA[0][i] = (unsigned)(R * PB + C * 2); voffA[1][i] = voffA[0][i] + (unsigned)hstep; nvoffA[0][i] = voffA[0][i]; nvoffA[1][i] = voffA[1][i];
        if (Epi::PERM == 2) { const int rb0 = 64 * (R >> 5) + perm32(R & 31); voffB[i] = (unsigned)(rb0 * PB + C * 2); }
        else { const int Rb = (R & ~31) + perm32(R & 31); voffB[i] = (unsigned)(Rb * PB + C * 2); } }
    const size_t bstep = Epi::PERM == 2 ? (size_t)32 * PB : hstep;
    const size_t kstep = 128;
    const unsigned ldsw = (unsigned)wid * 1024u, ldsu = (unsigned)(size_t)lds;
    const int aoff = lds_byte(wr * 64 + fr, fq * 8), boff = lds_byte(wc * 32 + fr, fq * 8);
#define PG8_SA(b, h) (((b) * 2 + (h)) * HTB)
#define PG8_SB(b, h) ((4 + (b) * 2 + (h)) * HTB)
#define PG8_STAGE(bufoff, gbase, voff) do { _Pragma("unroll") for (int _i = 0; _i < 2; ++_i) { unsigned _keep; \
        asm volatile("s_mov_b32 %0, m0\n\ts_mov_b32 m0, %3\n\tglobal_load_lds_dwordx4 %1, %2\n\ts_mov_b32 m0, %0" : "=&s"(_keep) : "v"((voff)[_i]), "s"((const char*)(gbase)), "s"(ldsu + (unsigned)(bufoff) + ldsw + _i * 8192u) : "memory"); } } while (0)
#define PG8_LDA(dst, b, h) do { _Pragma("unroll") for (int m = 0; m < 4; ++m) _Pragma("unroll") for (int k = 0; k < 2; ++k) dst[m][k] = *(const LAS bf16x8*)(lds + PG8_SA(b, h) + aoff + m * 2048 + k * 1024); } while (0)
#define PG8_LDB(dst, b, h) do { _Pragma("unroll") for (int n = 0; n < 2; ++n) _Pragma("unroll") for (int k = 0; k < 2; ++k) dst[n][k] = *(const LAS bf16x8*)(lds + PG8_SB(b, h) + boff + n * 2048 + k * 1024); } while (0)
#define PG8_MMA(ai, bj, At, Bt) do { __builtin_amdgcn_s_setprio(1); _Pragma("unroll") for (int m = 0; m < 4; ++m) _Pragma("unroll") for (int n = 0; n < 2; ++n) _Pragma("unroll") for (int k = 0; k < 2; ++k) \
        { if constexpr (KIND == 1) acc[ai][bj][m][n] = __builtin_bit_cast(ACC, __builtin_amdgcn_mfma_i32_16x16x64_i8(__builtin_bit_cast(i32x4, Bt[n][k]), __builtin_bit_cast(i32x4, At[m][k]), __builtin_bit_cast(i32x4, acc[ai][bj][m][n]), 0, 0, 0)); \
          else if constexpr (KIND == 2) { if (k == 0) { const i32x8 b8_ = __builtin_shufflevector(__builtin_bit_cast(i32x4, Bt[n][0]), __builtin_bit_cast(i32x4, Bt[n][1]), 0, 1, 2, 3, 4, 5, 6, 7), a8_ = __builtin_shufflevector(__builtin_bit_cast(i32x4, At[m][0]), __builtin_bit_cast(i32x4, At[m][1]), 0, 1, 2, 3, 4, 5, 6, 7); \
              asm volatile("v_mfma_f32_16x16x128_f8f6f4 %0, %1, %2, %0" : "+v"(acc[ai][bj][m][n]) : "v"(b8_), "v"(a8_)); } }     \
          else acc[ai][bj][m][n] = __builtin_bit_cast(ACC, __builtin_amdgcn_mfma_f32_16x16x32_bf16(Bt[n][k], At[m][k], __builtin_bit_cast(f32x4, acc[ai][bj][m][n]), 0, 0, 0)); } __builtin_amdgcn_s_setprio(0); } while (0)
#define PG8_WAIT_V(n) asm volatile("s_waitcnt vmcnt(" #n ")" ::: "memory")
#define PG8_WAIT_L(n) asm volatile("s_waitcnt lgkmcnt(" #n ")" ::: "memory")
#define PG8_BAR __builtin_amdgcn_s_barrier()
#define PG8_SCHED __builtin_amdgcn_sched_barrier(0)
#define PG8_GOFF(dst, slot, nv) do { const LAS unsigned* _e = (const LAS unsigned*)(lds + META_OFF + (slot) * META_SLOT); int _tq = tid; asm volatile("" : "+v"(_tq)); _Pragma("unroll") for (int _i = 0; _i < 2; ++_i) { int _R, _C; stage_rc(_tq * 16 + _i * 8192, _R, _C); \
        _Pragma("unroll") for (int _h = 0; _h < 2; ++_h) { const int _r = _h * HALF + _R; const unsigned _en = _e[_r]; const unsigned _row = (_r < (nv)) ? (_en >> 1) : 0u; dst[_h][_i] = _row * (unsigned)PB + (unsigned)_C * 2u; } } } while (0)
    Unit cur, nxt; int ui = 0;
    if (!S.next(0, cur)) return;
    typedef typename std::conditional<KIND == 1, i32x4, f32x4>::type ACC;
    ACC acc[2][2][4][2];
#pragma unroll
    for (int a = 0; a < 2; ++a)
#pragma unroll
        for (int b = 0; b < 2; ++b)
#pragma unroll
            for (int m = 0; m < 4; ++m)
#pragma unroll
                for (int n = 0; n < 2; ++n) acc[a][b][m][n] = (ACC){0, 0, 0, 0};
    bf16x8 At[4][2], B0[2][2], B1[2][2];
    const char* cA = cur.A; const char* cB = cur.B;
    int slot_cur = 0;
    PG8_STAGE(PG8_SB(0, 0), cB, voffB); PG8_STAGE(PG8_SB(0, 1), cB + bstep, voffB);
    if constexpr (!GATHER) { PG8_STAGE(PG8_SA(0, 0), cA, voffA[0]); PG8_STAGE(PG8_SA(0, 1), cA, voffA[1]); }
    if constexpr (META || SCALES) {
        if constexpr (META) { if (wid == 0) __builtin_amdgcn_global_load_lds(cur.meta + lane * 4, (LAS unsigned*)(lds + META_OFF), 16, 0, 0); }
        if constexpr (SCALES) { if (wid == 1) __builtin_amdgcn_global_load_lds((const unsigned*)cur.rs + lane * 4, (LAS unsigned*)(lds + META_OFF + 1024), 16, 0, 0);
                                if (wid == 2) __builtin_amdgcn_global_load_lds((const unsigned*)cur.cs + lane * 4, (LAS unsigned*)(lds + META_OFF + 2048), 16, 0, 0); }
        PG8_WAIT_V(0); __syncthreads();
        if constexpr (GATHER) PG8_GOFF(voffA, 0, cur.nvalid);
    }
    if constexpr (GATHER) { PG8_STAGE(PG8_SA(0, 0), cA, voffA[0]); PG8_STAGE(PG8_SA(0, 1), cA, voffA[1]); }
    if (wr == 1) PG8_BAR;
    PG8_WAIT_V(2); PG8_BAR;
    PG8_STAGE(PG8_SB(1, 0), cB + kstep, voffB); PG8_STAGE(PG8_SA(1, 0), cA + kstep, voffA[0]); PG8_STAGE(PG8_SB(1, 1), cB + bstep + kstep, voffB);
    PG8_WAIT_V(6); PG8_BAR;
    for (;;) {
        const bool has_next = S.next(ui + 1, nxt);
        const char* nA = has_next ? nxt.A : cA; const char* nB = has_next ? nxt.B : cB;
        int slot_nxt = slot_cur + 1; if (slot_nxt == 3) slot_nxt = 0;
        if constexpr (META) { if (has_next && wid == 0) __builtin_amdgcn_global_load_lds(nxt.meta + lane * 4, (LAS unsigned*)(lds + META_OFF + slot_nxt * META_SLOT), 16, 0, 0); }
        if constexpr (SCALES) { if (has_next && wid == 1) __builtin_amdgcn_global_load_lds((const unsigned*)nxt.rs + lane * 4, (LAS unsigned*)(lds + META_OFF + slot_nxt * META_SLOT + 1024), 16, 0, 0);
                                if (has_next && wid == 2) __builtin_amdgcn_global_load_lds((const unsigned*)nxt.cs + lane * 4, (LAS unsigned*)(lds + META_OFF + slot_nxt * META_SLOT + 2048), 16, 0, 0); }
        for (int t = 0; t < nt; t += 2) {
            const bool last = (t == nt - 2);
            const char* a1 = cA + (size_t)(t + 1) * kstep;
            const char* a2 = last ? nA : cA + (size_t)(t + 2) * kstep; const char* b2 = last ? nB : cB + (size_t)(t + 2) * kstep;
            const char* a3 = a2 + kstep; const char* b3 = b2 + kstep;
            unsigned o2[2][2];
            if constexpr (GATHER) { if (last && has_next) PG8_GOFF(nvoffA, slot_nxt, nxt.nvalid); }
#pragma unroll
            for (int h = 0; h < 2; ++h)
#pragma unroll
                for (int i = 0; i < 2; ++i) o2[h][i] = (GATHER && last && has_next) ? nvoffA[h][i] : voffA[h][i];
            PG8_LDB(B0, 0, 0); PG8_LDB(B1, 0, 1); PG8_SCHED; PG8_LDA(At, 0, 0); PG8_STAGE(PG8_SA(1, 1), a1, voffA[1]);
            PG8_WAIT_V(8); PG8_WAIT_L(0); PG8_BAR; PG8_MMA(0, 0, At, B0); PG8_MMA(0, 1, At, B1); PG8_BAR; PG8_SCHED;
            PG8_LDA(At, 0, 1); PG8_STAGE(PG8_SB(0, 0), b2, voffB); PG8_STAGE(PG8_SB(0, 1), b2 + bstep, voffB); PG8_STAGE(PG8_SA(0, 0), a2, o2[0]);
            PG8_WAIT_V(8); PG8_WAIT_L(0); PG8_BAR; PG8_MMA(1, 0, At, B0); PG8_MMA(1, 1, At, B1); PG8_BAR; PG8_SCHED;
            PG8_LDB(B0, 1, 0); PG8_LDB(B1, 1, 1); PG8_SCHED; PG8_LDA(At, 1, 0); PG8_STAGE(PG8_SA(0, 1), a2, o2[1]);
            PG8_WAIT_V(8); PG8_WAIT_L(0); PG8_BAR; PG8_MMA(0, 0, At, B0); PG8_MMA(0, 1, At, B1); PG8_BAR; PG8_SCHED;
            PG8_LDA(At, 1, 1); PG8_STAGE(PG8_SB(1, 0), b3, voffB); PG8_STAGE(PG8_SB(1, 1), b3 + bstep, voffB); PG8_STAGE(PG8_SA(1, 0), a3, o2[0]);
            PG8_WAIT_V(8); PG8_WAIT_L(0); PG8_BAR; PG8_MMA(1, 0, At, B0); PG8_MMA(1, 1, At, B1); PG8_BAR; PG8_SCHED;
        }
        if (wr == 0) PG8_BAR;
        if constexpr (KIND == 2) asm volatile("s_nop 7\n\ts_nop 7\n\ts_nop 3" ::: "memory");
        E(acc, cur, wr, wc, fr, fq, lds, slot_cur);
        if (!has_next) break;
#pragma unroll
        for (int a = 0; a < 2; ++a)
#pragma unroll
            for (int b = 0; b < 2; ++b)
#pragma unroll
                for (int m = 0; m < 4; ++m)
#pragma unroll
                    for (int n = 0; n < 2; ++n) acc[a][b][m][n] = (ACC){0, 0, 0, 0};
        cur = nxt; cA = nA; cB = nB; ++ui; slot_cur = slot_nxt;
        if constexpr (GATHER) {
#pragma unroll
            for (int h = 0; h < 2; ++h)
#pragma unroll
                for (int i = 0; i < 2; ++i) voffA[h][i] = nvoffA[h][i]; }
        if (wr == 1) PG8_BAR;
    }
    PG8_WAIT_V(0);
    PG8_BAR;
#undef PG8_SA
#undef PG8_SB
#undef PG8_STAGE
#undef PG8_LDA
#undef PG8_LDB
#undef PG8_MMA
#undef PG8_WAIT_V
#undef PG8_WAIT_L
#undef PG8_BAR
#undef PG8_SCHED
#undef PG8_GOFF
}
}

#define XB_TMO      128
#define XB_XCNT(j)  (256  + 64 * (j))
#define XB_XSUB(j)  (1280 + 64 * (j))
#define XB_XGEN(j)  (2304 + 64 * (j))
#define XB_TOP      3328
#define XB_TOPGEN   3392
#define XCD_BAR_WORDS 3456
#define XB_SPIN_CAP (1u << 22)
__device__ __forceinline__ unsigned xb_ld(unsigned* p)              { return __hip_atomic_load(p, __ATOMIC_RELAXED, __HIP_MEMORY_SCOPE_AGENT); }
__device__ __forceinline__ unsigned xb_add(unsigned* p, unsigned v) { return __hip_atomic_fetch_add(p, v, __ATOMIC_RELAXED, __HIP_MEMORY_SCOPE_AGENT); }
__device__ __forceinline__ unsigned xb_xcc_id() { return (unsigned)__builtin_amdgcn_s_getreg((3 << 11) | 20) & 0xFu; }
#define XB_SPIN(cond, bar) do { unsigned _sp = 0; while (cond) { __builtin_amdgcn_s_sleep(1); \
    if ((++_sp & 255u) == 0u) { if (xb_ld(&(bar)[XB_TMO])) break; if (_sp > XB_SPIN_CAP) { atomicAdd(&(bar)[XB_TMO], 1u); break; } } } } while (0)
struct XcdBarrier { unsigned* bar; unsigned x; volatile LAS unsigned* st; };
__device__ __forceinline__ XcdBarrier xcd_barrier_post(unsigned* bar, volatile LAS unsigned* st) {
    XcdBarrier b; b.bar = bar; b.x = xb_xcc_id(); b.st = st;
    if (threadIdx.x == 0) (void)xb_add(&bar[XB_XCNT(b.x)], 1u);
    return b;
}
__device__ __forceinline__ void xcd_barrier_complete(unsigned* bar, unsigned x, unsigned& nloc, unsigned& nx) {
    const unsigned G = gridDim.x * gridDim.y * gridDim.z;
    unsigned sum, cnt, mine, sp = 0u;
    for (;;) {
        sum = 0u; cnt = 0u; mine = 0u;
#pragma unroll
        for (unsigned j = 0; j < 16; ++j) { const unsigned c = xb_ld(&bar[XB_XCNT(j)]); sum += c; cnt += (c > 0u) ? 1u : 0u; mine = (j == x) ? c : mine; }
        if (sum == G) break;
        __builtin_amdgcn_s_sleep(1);
        if ((++sp & 255u) == 0u) { if (xb_ld(&bar[XB_TMO])) break; if (sp > XB_SPIN_CAP) { atomicAdd(&bar[XB_TMO], 1u); break; } }
    }
    nloc = mine > 0u ? mine : 1u; nx = cnt > 0u ? cnt : 1u;
}
__device__ __forceinline__ void xcd_barrier(const XcdBarrier& b) {
    asm volatile("s_waitcnt vmcnt(0)" ::: "memory");
    __syncthreads();
    if (threadIdx.x == 0) {
        unsigned* bar = b.bar;
        __builtin_amdgcn_s_waitcnt(0);
        unsigned nloc = b.st[0], nx = b.st[1];
        if (nloc == 0u) { xcd_barrier_complete(bar, b.x, nloc, nx); b.st[0] = nloc; b.st[1] = nx; }
        const unsigned old = xb_add(&bar[XB_XSUB(b.x)], 1u);
        const unsigned gen = old / nloc;
        if (old + 1u == (gen + 1u) * nloc) {
            __builtin_amdgcn_fence(__ATOMIC_RELEASE, "agent");
            asm volatile("s_waitcnt vmcnt(0)" ::: "memory");
            const unsigned og = xb_add(&bar[XB_TOP], 1u);
            const unsigned tg = og / nx;
            asm volatile("buffer_inv sc1" ::: "memory");
            if (og + 1u == (tg + 1u) * nx) xb_add(&bar[XB_TOPGEN], 1u);
            else XB_SPIN(xb_ld(&bar[XB_TOPGEN]) == tg, bar);
            asm volatile("" ::: "memory");
            xb_add(&bar[XB_XGEN(b.x)], 1u);
            asm volatile("s_waitcnt vmcnt(0)" ::: "memory");
        } else {
            asm volatile("buffer_inv sc1" ::: "memory");
            XB_SPIN(xb_ld(&bar[XB_XGEN(b.x)]) == gen, bar);
            asm volatile("s_waitcnt vmcnt(0)" ::: "memory");
        }
    }
    __syncthreads();
}
constexpr int CW_BAR = 4096;

typedef short s16x4 __attribute__((ext_vector_type(4)));
constexpr int VN_PITCH = 1056;
__device__ __forceinline__ s16x4 ds_tr16(LAS unsigned char* p) { return __builtin_bit_cast(s16x4, __builtin_amdgcn_ds_read_tr16_b64_v4i16((LAS s16x4*)p)); }
__device__ __forceinline__ bf16x8 cat8(s16x4 a, s16x4 b) { bf16x8 r; r[0] = a[0]; r[1] = a[1]; r[2] = a[2]; r[3] = a[3]; r[4] = b[0]; r[5] = b[1]; r[6] = b[2]; r[7] = b[3]; return r; }
__device__ __forceinline__ void sgu_unit(const Ptrs& P, LAS unsigned char* lds, unsigned char* ws, int t0, int lane, int wave, int l15, int g, float vb) {
    const unsigned char* Z = (const unsigned char*)(ws + WS_Z); signed char* CATQ = (signed char*)(ws + WS_CAT);
    {
        LAS float* gl = (LAS float*)(lds + 128 * VN_PITCH); LAS float* bl = gl + 512;
        if (threadIdx.x < 128) { ((LAS f32x4*)gl)[threadIdx.x] = ((const f32x4*)P.sgu_ln_g)[threadIdx.x]; ((LAS f32x4*)bl)[threadIdx.x] = ((const f32x4*)P.sgu_ln_b)[threadIdx.x]; }
        const int j = wave * 16 + l15; const unsigned char* vrow = Z + ((size_t)t0 + j) * 1536 + 512 + 128 * g;
        u32x2 raw[16];
#pragma unroll
        for (int i = 0; i < 16; ++i) raw[i] = *(const u32x2*)(vrow + 8 * i);
        float s1 = 0.f, s2 = 0.f;
#pragma unroll
        for (int i = 0; i < 16; ++i) { float v[8]; unpack_fp8x8(raw[i], v);
#pragma unroll
            for (int q = 0; q < 8; ++q) { s1 += v[q]; s2 += v[q] * v[q]; } }
        s1 += __shfl_xor(s1, 16); s1 += __shfl_xor(s1, 32); s2 += __shfl_xor(s2, 16); s2 += __shfl_xor(s2, 32);
        const float mean = s1 * (1.f / 512.f), rstd = rsqrtf(fmaxf(s2 * (1.f / 512.f) - mean * mean, 0.f) + LN_EPS * (Z_SCALE * Z_SCALE));
        __syncthreads();
#pragma unroll
        for (int i = 0; i < 16; ++i) { u32x2 rk = raw[i]; asm volatile("" : "+v"(rk)); float v[8]; unpack_fp8x8(rk, v);
            const f32x4 g0 = *(const LAS f32x4*)(gl + 128 * g + 8 * i), g1 = *(const LAS f32x4*)(gl + 128 * g + 8 * i + 4), b0 = *(const LAS f32x4*)(bl + 128 * g + 8 * i), b1 = *(const LAS f32x4*)(bl + 128 * g + 8 * i + 4);
#pragma unroll
            for (int q = 0; q < 8; ++q) { const float gq = q < 4 ? g0[q & 3] : g1[q & 3], bq = q < 4 ? b0[q & 3] : b1[q & 3]; const float scl = rstd * gq; v[q] = v[q] * scl + (bq - mean * scl); }
            *(LAS u32x4*)(lds + j * VN_PITCH + (128 * g + 8 * i) * 2) = pack8(v); }
    }
    __syncthreads();
    {
        const int h = wave >> 1, dbase = h * 128 + (wave & 1) * 64, q = l15 >> 2, pp = l15 & 3;
        bf16x8 af[4][4];
#pragma unroll
        for (int mt = 0; mt < 4; ++mt)
#pragma unroll
            for (int ks = 0; ks < 4; ++ks) { LAS unsigned char* a0 = lds + (32 * ks + 4 * g + q) * VN_PITCH + (dbase + 16 * mt + 4 * pp) * 2; af[mt][ks] = cat8(ds_tr16(a0), ds_tr16(a0 + 16 * VN_PITCH)); }
        const bf16* SW = (const bf16*)(ws + WS_WSGU) + (size_t)(h * 128 + l15) * 128 + 8 * g;
        asm volatile("s_waitcnt lgkmcnt(0)" ::: "memory"); __syncthreads();
#pragma unroll
        for (int it = 0; it < 8; ++it) { const int nks = it < 4 ? 2 : 4;
            const int i = 16 * it + l15; const size_t tok = (size_t)t0 + i;
            bf16x8 bfr[4]; unsigned uw[4];
#pragma unroll
            for (int ks = 0; ks < 4; ++ks) if (ks < nks) bfr[ks] = *(const bf16x8*)(SW + (size_t)(16 * it) * 128 + 32 * ks);
#pragma unroll
            for (int mt = 0; mt < 4; ++mt) uw[mt] = *(const unsigned*)(Z + tok * 1536 + dbase + 16 * mt + 4 * g);
            const float bias = P.sgu_b[h * 128 + i] * (1.f / Z_SCALE);
            f32x4 acc[4];
#pragma unroll
            for (int mt = 0; mt < 4; ++mt) acc[mt] = (f32x4){0.f, 0.f, 0.f, 0.f};
#pragma unroll
            for (int ks = 0; ks < 4; ++ks) if (ks < nks) {
#pragma unroll
                for (int mt = 0; mt < 4; ++mt) acc[mt] = __builtin_amdgcn_mfma_f32_16x16x32_bf16(af[mt][ks], bfr[ks], acc[mt], 0, 0, 0); }
#pragma unroll
            for (int mt = 0; mt < 4; ++mt) { const int d = dbase + 16 * mt + 4 * g;
                const auto ul = __builtin_amdgcn_cvt_pk_f32_fp8((int)uw[mt], false), uh = __builtin_amdgcn_cvt_pk_f32_fp8((int)uw[mt], true);
                u32x2 o; o.x = pg8::cvt_pk_bf16(ul[0] * (acc[mt][0] + bias), ul[1] * (acc[mt][1] + bias)); o.y = pg8::cvt_pk_bf16(uh[0] * (acc[mt][2] + bias), uh[1] * (acc[mt][3] + bias));
                *(LAS u32x2*)(lds + i * VN_PITCH + d * 2) = o; } }
    }
    __syncthreads();
    {
        LAS float* rowsc = (LAS float*)(lds + ROWSC_OFF);
#pragma unroll 4
        for (int rr = 0; rr < 16; ++rr) { const int i = wave * 16 + rr; float v[8]; unpack8(*(const LAS u32x4*)(lds + i * VN_PITCH + lane * 16), v);
            float mx = 0.f;
#pragma unroll
            for (int q = 0; q < 8; ++q) mx = fmaxf(mx, fabsf(v[q]));
            mx = fmaxf(wave_max(mx), vb); const float scale = mx > 0.f ? mx * (1.f / 127.f) : 1.f, inv = 1.f / scale;
            u32x2 qv; qv.x = pack4q(v[0] * inv, v[1] * inv, v[2] * inv, v[3] * inv); qv.y = pack4q(v[4] * inv, v[5] * inv, v[6] * inv, v[7] * inv);
            *(u32x2*)(CATQ + ((size_t)t0 + i) * D + lane * 8) = qv;
            if (lane == 0) { ((float*)(ws + WS_CSCALE))[t0 + i] = scale; rowsc[(t0 + i) & 255] = scale; } }
    }
}
__device__ __forceinline__ void mixer_pair(const Ptrs& P, LAS unsigned char* lds, int pair, int layer) {
    int tid_ = threadIdx.x; asm volatile("" : "+v"(tid_));
    const int tid = tid_, lane = tid & 63, wave = __builtin_amdgcn_readfirstlane(tid >> 6), l15 = lane & 15, g = lane >> 4;
    unsigned char* ws = fresh(P.ws); const unsigned char* Z = (const unsigned char*)(ws + WS_Z); signed char* CATQ = (signed char*)(ws + WS_CAT);
    const int t0 = pair * 256, b = t0 / SEQ; const int ldz = 1536, qoff = 1024;
    const float vb = __builtin_bit_cast(float, __hip_atomic_load((const unsigned*)(ws + WS_CTL) + CW_VBOUND + layer * 16 + b, __ATOMIC_RELAXED, __HIP_MEMORY_SCOPE_AGENT));
    LAS float* rowsc = (LAS float*)(lds + ROWSC_OFF);
#ifndef REP_SGU
#define REP_SGU 1
#endif
#ifndef REP_CONV
#define REP_CONV 1
#endif
#ifndef REP_ATT
#define REP_ATT 1
#endif
    if (layer == 0) {
#pragma unroll 1
        for (int rep = 0; rep < freshi(REP_SGU); ++rep) {
        __syncthreads();
        sgu_unit(P, lds, ws, t0, lane, wave, l15, g, vb);
        __syncthreads();
        sgu_unit(P, lds, ws, t0 + 128, lane, wave, l15, g, vb); }
    } else {
#pragma unroll 1
        for (int rep = 0; rep < freshi(REP_CONV); ++rep) { conv_unit(P, lds, 2 * pair, vb); conv_unit(P, lds, 2 * pair + 1, vb); } }
    int kbase[4], vb0[4], vb1[4];
#pragma unroll
    for (int j = 0; j < 4; ++j) { kbase[j] = l15 * 256 + (((4 * j + g) ^ l15) << 4); vb0[j] = 65536 + l15 * 512 + (g & 1) * 8 + (((4 * j + (g >> 1)) ^ l15) << 4); vb1[j] = 65536 + l15 * 512 + (g & 1) * 8 + (((4 * j + (g >> 1) + 2) ^ l15) << 4); }
    const char* KM = (const char*)(ws + WS_KMAT) + (size_t)(b * 256) * 2048 + (size_t)(layer * 512) * 2;
    const char* VT = (const char*)(ws + WS_VT) + (size_t)(layer * 512) * 8192 + (size_t)(b * 256) * 2;
    const unsigned ldsu = (unsigned)(size_t)lds;
#define ATT_DMA1(voff, gbase, ldsoff) do { unsigned keep_; asm volatile("s_mov_b32 %0, m0\n\ts_mov_b32 m0, %3\n\tglobal_load_lds_dwordx4 %1, %2\n\ts_mov_b32 m0, %0" : "=&s"(keep_) : "v"(voff), "s"(gbase), "s"(ldsu + (unsigned)(ldsoff)) : "memory"); } while (0)
#define ATT_DMA_K(h_) do { int ln_ = lane; asm volatile("" : "+v"(ln_)); const char* gb_ = KM + (h_) * 256; _Pragma("unroll") for (int ii = 0; ii < 8; ++ii) { const int I = wave * 8 + ii; const int row = 4 * I + (ln_ >> 4), c16 = (ln_ & 15) ^ (row & 15); \
        ATT_DMA1((unsigned)(row * 2048 + c16 * 16), gb_, I * 1024); } } while (0)
#define ATT_DMA_V(h_) do { int ln_ = lane; asm volatile("" : "+v"(ln_)); const char* gb_ = VT + (size_t)((h_) * 128) * 8192; _Pragma("unroll") for (int ii = 0; ii < 8; ++ii) { const int I = wave * 8 + ii; const int row = 2 * I + (ln_ >> 5), c32 = (ln_ & 31) ^ (row & 15); \
        ATT_DMA1((unsigned)(row * 8192 + c32 * 16), gb_, 65536 + I * 1024); } } while (0)
#define ATT_LDQ(h_) do { _Pragma("unroll") for (int su = 0; su < 2; ++su) _Pragma("unroll") for (int ks = 0; ks < 4; ++ks) qr[su][ks] = *(const u32x2*)(Z + ((size_t)t0 + su * 128 + wave * 16 + l15) * ldz + qoff + (h_) * 128 + 32 * ks + 8 * g); } while (0)
    const int nheads = NH * freshi(REP_ATT);
    u32x2 qr[2][4];
    __syncthreads();
#define ATT_QF_USE() asm volatile("" : "+v"(qr[0][0]), "+v"(qr[0][1]), "+v"(qr[0][2]), "+v"(qr[0][3]), "+v"(qr[1][0]), "+v"(qr[1][1]), "+v"(qr[1][2]), "+v"(qr[1][3]))
    ATT_DMA_K(0); ATT_LDQ(0); ATT_QF_USE(); ATT_DMA_V(0);
#pragma unroll 1
    for (int hh = 0; hh < nheads; ++hh) { const int h = hh & 3, hn = (hh + 1) & 3; const bool more = hh + 1 < nheads;
        if (hh == 0) asm volatile("s_waitcnt vmcnt(16)" ::: "memory"); else asm volatile("s_waitcnt vmcnt(32)" ::: "memory");
        __builtin_amdgcn_s_barrier();
        __builtin_amdgcn_sched_barrier(0);
        bf16x8 qf[2][4];
#pragma unroll
        for (int su = 0; su < 2; ++su)
#pragma unroll
            for (int ks = 0; ks < 4; ++ks) { float f[8]; unpack_fp8x8(qr[su][ks], f); u32x4 w; w.x = pg8::cvt_pk_bf16(f[0], f[1]); w.y = pg8::cvt_pk_bf16(f[2], f[3]); w.z = pg8::cvt_pk_bf16(f[4], f[5]); w.w = pg8::cvt_pk_bf16(f[6], f[7]); qf[su][ks] = __builtin_bit_cast(bf16x8, w); }
        f32x4 S[2][16];
        {
            bf16x8 kf[2][4];
#pragma unroll
            for (int q = 0; q < 4; ++q) kf[0][q] = *(const LAS bf16x8*)(lds + kbase[q]);
#pragma unroll
            for (int kt = 0; kt < 16; ++kt) {
                if (kt < 15) {
#pragma unroll
                    for (int q = 0; q < 4; ++q) kf[(kt + 1) & 1][q] = *(const LAS bf16x8*)(lds + kbase[q] + 4096 * (kt + 1)); }
                __builtin_amdgcn_sched_barrier(0);
                __builtin_amdgcn_s_setprio(1);
#pragma unroll
                for (int ks = 0; ks < 4; ++ks)
#pragma unroll
                    for (int su = 0; su < 2; ++su) S[su][kt] = __builtin_amdgcn_mfma_f32_16x16x32_bf16(kf[kt & 1][ks], qf[su][ks], ks == 0 ? (f32x4){0.f, 0.f, 0.f, 0.f} : S[su][kt], 0, 0, 0);
                __builtin_amdgcn_s_setprio(0);
                __builtin_amdgcn_sched_barrier(0);
            }
        }
        asm volatile("s_waitcnt lgkmcnt(0)" ::: "memory");
        __builtin_amdgcn_s_barrier();
        __builtin_amdgcn_sched_barrier(0);
        if (more) ATT_DMA_K(hn);
        float inv[2];
        bf16x8 pf[2][8];
#pragma unroll
        for (int su = 0; su < 2; ++su) {
            float mx = -3.0e38f;
#pragma unroll
            for (int kt = 0; kt < 16; ++kt) mx = fmaxf(fmaxf(mx, fmaxf(S[su][kt][0], S[su][kt][1])), fmaxf(S[su][kt][2], S[su][kt][3]));
            mx = fmaxf(mx, __shfl_xor(mx, 16)); mx = fmaxf(mx, __shfl_xor(mx, 32));
            const float sc = 0.08838834764831845f * 1.4426950408889634f / Z_SCALE; const float mxs = mx * sc; float sum = 0.f;
#pragma unroll
            for (int kt = 0; kt < 16; ++kt)
#pragma unroll
                for (int r = 0; r < 4; ++r) { const float pv = __builtin_amdgcn_exp2f(S[su][kt][r] * sc - mxs); S[su][kt][r] = pv; sum += pv; }
            sum += __shfl_xor(sum, 16); sum += __shfl_xor(sum, 32);
            inv[su] = 1.f / (sum * rowsc[su * 128 + wave * 16 + l15]);
#pragma unroll
            for (int sp = 0; sp < 8; ++sp) { u32x4 w; w.x = pg8::cvt_pk_bf16(S[su][2 * sp][0], S[su][2 * sp][1]); w.y = pg8::cvt_pk_bf16(S[su][2 * sp][2], S[su][2 * sp][3]); w.z = pg8::cvt_pk_bf16(S[su][2 * sp + 1][0], S[su][2 * sp + 1][1]); w.w = pg8::cvt_pk_bf16(S[su][2 * sp + 1][2], S[su][2 * sp + 1][3]); pf[su][sp] = __builtin_bit_cast(bf16x8, w); }
        }
        if (more) ATT_LDQ(hn);
        if (more) asm volatile("s_waitcnt vmcnt(16)" ::: "memory"); else asm volatile("s_waitcnt vmcnt(0)" ::: "memory");
        __builtin_amdgcn_s_barrier();
        __builtin_amdgcn_sched_barrier(0);
        {
            s16x4 vf[2][8];
#pragma unroll
            for (int q = 0; q < 4; ++q) { vf[0][2 * q] = *(const LAS s16x4*)(lds + vb0[q]); vf[0][2 * q + 1] = *(const LAS s16x4*)(lds + vb1[q]); }
            f32x4 O[2];
#pragma unroll
            for (int bt = 0; bt < 16; ++bt) { const int dt = bt >> 1, hf = bt & 1;
                if (bt < 15) { const int nd = (bt + 1) >> 1, nh = (bt + 1) & 1;
#pragma unroll
                    for (int q = 0; q < 4; ++q) { vf[(bt + 1) & 1][2 * q] = *(const LAS s16x4*)(lds + vb0[q] + 8192 * nd + 256 * nh); vf[(bt + 1) & 1][2 * q + 1] = *(const LAS s16x4*)(lds + vb1[q] + 8192 * nd + 256 * nh); } }
                __builtin_amdgcn_sched_barrier(0);
                __builtin_amdgcn_s_setprio(1);
#pragma unroll
                for (int q = 0; q < 4; ++q)
#pragma unroll
                    for (int su = 0; su < 2; ++su) O[su] = __builtin_amdgcn_mfma_f32_16x16x32_bf16(cat8(vf[bt & 1][2 * q], vf[bt & 1][2 * q + 1]), pf[su][4 * hf + q], (hf == 0 && q == 0) ? (f32x4){0.f, 0.f, 0.f, 0.f} : O[su], 0, 0, 0);
                __builtin_amdgcn_s_setprio(0);
                if (hf == 1) {
#pragma unroll
                    for (int su = 0; su < 2; ++su) { const size_t tokrow = (size_t)t0 + su * 128 + wave * 16 + l15;
                        *(unsigned*)(CATQ + tokrow * D + 512 + h * 128 + 16 * dt + 4 * g) = pack4q(O[su][0] * inv[su], O[su][1] * inv[su], O[su][2] * inv[su], O[su][3] * inv[su]); } }
                __builtin_amdgcn_sched_barrier(0);
            }
        }
        asm volatile("s_waitcnt lgkmcnt(0)" ::: "memory");
        __builtin_amdgcn_s_barrier();
        __builtin_amdgcn_sched_barrier(0);
        ATT_QF_USE();
        __builtin_amdgcn_sched_barrier(0);
        if (more) ATT_DMA_V(hn);
    }
#undef ATT_DMA1
#undef ATT_DMA_K
#undef ATT_DMA_V
#undef ATT_LDQ
#undef ATT_QF_USE
}

constexpr int LDS_BYTES = 155648;
struct Args { Ptrs P; int ph_lo, ph_hi; };
__global__ void __launch_bounds__(512, 2) mk_fwd(Args args) {
    extern __shared__ __attribute__((aligned(16))) unsigned char lds_raw[];
    LAS unsigned char* lds = (LAS unsigned char*)lds_raw;
    const Ptrs& P = args.P;
    const int lo = args.ph_lo, hi = args.ph_hi;
#define G freshi((int)gridDim.x)
#define c freshi((int)blockIdx.x)
    volatile LAS unsigned* MISC = (volatile LAS unsigned*)(lds + LDS_BYTES - 64);
    if (threadIdx.x < 16) MISC[threadIdx.x] = 0u;
    __syncthreads();
    if (hi - lo > 1) (void)xcd_barrier_post((unsigned*)(args.P.ws + WS_CTL) + CW_BAR, MISC);
#define SEAM(k) do { if (IN(k) && (k) + 1 < hi) { XcdBarrier bar_; bar_.bar = (unsigned*)(args.P.ws + WS_CTL) + CW_BAR; bar_.x = xb_xcc_id(); bar_.st = (volatile LAS unsigned*)(lds + LDS_BYTES - 64); xcd_barrier(bar_); } } while (0)
#define LSEAM(k) do { if (IN(k) && (k) + 1 < hi) { asm volatile("s_waitcnt vmcnt(0)" ::: "memory"); __syncthreads(); } } while (0)
#ifndef PHMASK
#define PHMASK 0xffff
#endif
#define IN(k) (((PHMASK >> ((k) < 2 ? (k) : 2 + ((k) - 2) % 7)) & 1) && lo <= (k) && (k) < hi)
#ifndef REPMASK
#define REPMASK 0
#endif
#ifndef DUMMY_INPROJ
#define DUMMY_INPROJ 0
#endif
#ifndef SKIP_EPI
#define SKIP_EPI 0
#endif
#define KIDX(k) ((k) < 2 ? (k) : 2 + ((k) - 2) % 7)
#define GBAR() do { XcdBarrier bar_; bar_.bar = (unsigned*)(args.P.ws + WS_CTL) + CW_BAR; bar_.x = xb_xcc_id(); bar_.st = (volatile LAS unsigned*)(lds + LDS_BYTES - 64); xcd_barrier(bar_); } while (0)
#ifndef REPFIRST
#define REPFIRST 0
#endif
#define RUN(k, ...) do { if (REPFIRST && (((REPMASK) >> KIDX(k)) & 1)) { if (IN(k)) { const bool dry_ = freshi(1) != 0; (void)dry_; __VA_ARGS__ GBAR(); } } if (IN(k)) { const bool dry_ = false; (void)dry_; __VA_ARGS__ } if (!REPFIRST && (((REPMASK) >> KIDX(k)) & 1)) { if (IN(k)) { GBAR(); const bool dry_ = freshi(1) != 0; (void)dry_; __VA_ARGS__ } } } while (0)
    RUN(0, phase_prologue(P, lds, c, G, 0););
    SEAM(0);
    RUN(1, {
        unsigned char* ws = fresh(args.P.ws);
        const int ckv = c >= 128 ? c - 128 : 128 + c;
        pg8::SchedKV S{(const char*)(ws + WS_MEMB), (const char*)(ws + WS_WK), (const char*)(ws + WS_WV), (bf16*)(ws + WS_KMAT), (bf16*)(ws + WS_VT), G, ckv};
        pg8::EpiStore E{0, 0, (unsigned*)(ws + WS_CTL) + CW_VBOUND};
        pg8::gemm_phase<pg8::EpiStore, pg8::SchedKV, false, false>(lds, 2048, S, E);
        phase_prologue(P, lds, c, G, 1);
        asm volatile("s_waitcnt vmcnt(0)" ::: "memory"); __syncthreads();
    });
    { constexpr int layer = 0;
        const int pb = 2 + 7 * layer;
        RUN(pb, {
            unsigned char* ws = fresh(args.P.ws);
            const int N = layer == 0 ? 1536 : 2048;
            pg8::SchedPlain S{(const char*)(ws + WS_XQ), (const char*)(ws + (layer == 0 ? WS_WINA : WS_WINB)), (bf16*)(ws + WS_Z), T / 256, N / 256, 1024, 1536, G, c, (bf16*)nullptr, (const float*)(ws + WS_XSCALE), (const float*)(ws + WS_CS) + (layer == 0 ? 0 : 2048), true};
            pg8::EpiStoreF8z E{layer == 0 ? 4 : 0, layer == 0 ? 99 : 2, layer == 0 ? 99 : 6};
            pg8::gemm_phase<pg8::EpiStoreF8z, pg8::SchedPlain, false, false, 1, true>(lds, 1024, S, E);
            if (layer == 0 && c < 128) phase_prologue_b(P, lds, c, 128);
        });
        SEAM(pb);
        RUN(pb + 1, { for (int pair = c; pair < T / 256; pair += G) mixer_pair(P, lds, pair, layer); });
        LSEAM(pb + 1);
        RUN(pb + 2, {
            unsigned char* ws = fresh(args.P.ws);
            pg8::SchedPlain S{(const char*)(ws + WS_CAT), (const char*)(ws + WS_WOUT) + (size_t)layer * 1024 * 1024, (bf16*)(ws + WS_H1), T / 256, 4, 1024, 1024, G, c, (bf16*)nullptr, (const float*)(ws + WS_CSCALE), (const float*)(ws + WS_CSOUT) + layer * 1024, true};
            constexpr bool rq8 = layer == 0 ? (RES_Q8_L0 != 0) : (RES_Q8_L1 != 0);
            if constexpr (rq8) { pg8::EpiResidQ8 E{(const unsigned char*)(ws + WS_XQ), (const float*)(ws + WS_XSCALE)};
                pg8::gemm_phase<pg8::EpiResidQ8, pg8::SchedPlain, false, false, 1, true>(lds, 1024, S, E); }
            else { pg8::EpiResidI8 E{(const bf16*)(ws + WS_XB)};
                pg8::gemm_phase<pg8::EpiResidI8, pg8::SchedPlain, false, false, 1, true>(lds, 1024, S, E); }
        });
        LSEAM(pb + 2);
        RUN(pb + 3, phase_ln1_router(P, lds, c, G, layer, dry_););
        SEAM(pb + 3);
        RUN(pb + 4, {
            unsigned char* ws = fresh(args.P.ws);
            const unsigned* cnt = (const unsigned*)(ws + WS_CTL) + CW_CNT + layer * 1024;
            const int NT = pg8::moe_tables(lds, cnt);
            pg8::SchedMoE S{lds, (const char*)(ws + WS_X1Q), (const char*)(ws + WS_WGU) + (size_t)layer * NE * 1024 * 1024, (size_t)1024 * 1024, 1024, (bf16*)(ws + WS_HMOE), DE, (const unsigned*)(ws + WS_LIST), NT, G, c, true, (const float*)(ws + WS_LSCL), (const float*)(ws + WS_CSGU) + layer * NE * 1024};
            pg8::EpiSwiGLUI8 E{};
            pg8::gemm_phase<pg8::EpiSwiGLUI8, pg8::SchedMoE, true, true, 1, true>(lds, 1024, S, E);
            if (layer == 0) late_convert(P, lds, c, G, NT, false);
        });
        SEAM(pb + 4);
        RUN(pb + 5, {
            unsigned char* ws = fresh(args.P.ws);
            const unsigned* cnt = (const unsigned*)(ws + WS_CTL) + CW_CNT + layer * 1024;
            const int NT = pg8::moe_tables(lds, cnt);
            pg8::SchedMoE S{lds, (const char*)(ws + WS_HMOE), (const char*)(ws + WS_WD) + (size_t)layer * NE * 1024 * 512, (size_t)1024 * 512, 512, (bf16*)(ws + WS_Y), 1024, (const unsigned*)(ws + WS_LIST), NT, G, c, false, (const float*)(ws + WS_LSCL), (const float*)(ws + WS_CSD) + layer * NE * 1024};
            pg8::EpiScatterF8 E{};
            pg8::gemm_phase<pg8::EpiScatterF8, pg8::SchedMoE, false, true, 2, true>(lds, 512, S, E);
            if (layer == 0) late_convert(P, lds, c, G, NT, true);
        });
        SEAM(pb + 5);
        RUN(pb + 6, phase_ln2(P, c, G, layer););
        LSEAM(pb + 6);
    }
    { constexpr int layer = 1;
        const int pb = 2 + 7 * layer;
        RUN(pb, {
            unsigned char* ws = fresh(args.P.ws);
            const int N = layer == 0 ? 1536 : 2048;
            pg8::SchedPlain S{(const char*)(ws + WS_XQ), (const char*)(ws + (layer == 0 ? WS_WINA : WS_WINB)), (bf16*)(ws + WS_Z), T / 256, N / 256, 1024, 1536, G, c, (bf16*)nullptr, (const float*)(ws + WS_XSCALE), (const float*)(ws + WS_CS) + (layer == 0 ? 0 : 2048), true};
            pg8::EpiStoreF8z E{layer == 0 ? 4 : 0, layer == 0 ? 99 : 2, layer == 0 ? 99 : 6};
            pg8::gemm_phase<pg8::EpiStoreF8z, pg8::SchedPlain, false, false, 1, true>(lds, 1024, S, E);
            if (layer == 0 && c < 128) phase_prologue_b(P, lds, c, 128);
        });
        SEAM(pb);
        RUN(pb + 1, { for (int pair = c; pair < T / 256; pair += G) mixer_pair(P, lds, pair, layer); });
        LSEAM(pb + 1);
        RUN(pb + 2, {
            unsigned char* ws = fresh(args.P.ws);
            pg8::SchedPlain S{(const char*)(ws + WS_CAT), (const char*)(ws + WS_WOUT) + (size_t)layer * 1024 * 1024, (bf16*)(ws + WS_H1), T / 256, 4, 1024, 1024, G, c, (bf16*)nullptr, (const float*)(ws + WS_CSCALE), (const float*)(ws + WS_CSOUT) + layer * 1024, true};
            constexpr bool rq8 = layer == 0 ? (RES_Q8_L0 != 0) : (RES_Q8_L1 != 0);
            if constexpr (rq8) { pg8::EpiResidQ8 E{(const unsigned char*)(ws + WS_XQ), (const float*)(ws + WS_XSCALE)};
                pg8::gemm_phase<pg8::EpiResidQ8, pg8::SchedPlain, false, false, 1, true>(lds, 1024, S, E); }
            else { pg8::EpiResidI8 E{(const bf16*)(ws + WS_XB)};
                pg8::gemm_phase<pg8::EpiResidI8, pg8::SchedPlain, false, false, 1, true>(lds, 1024, S, E); }
        });
        LSEAM(pb + 2);
        RUN(pb + 3, phase_ln1_router(P, lds, c, G, layer, dry_););
        SEAM(pb + 3);
        RUN(pb + 4, {
            unsigned char* ws = fresh(args.P.ws);
            const unsigned* cnt = (const unsigned*)(ws + WS_CTL) + CW_CNT + layer * 1024;
            const int NT = pg8::moe_tables(lds, cnt);
            pg8::SchedMoE S{lds, (const char*)(ws + WS_X1Q), (const char*)(ws + WS_WGU) + (size_t)layer * NE * 1024 * 1024, (size_t)1024 * 1024, 1024, (bf16*)(ws + WS_HMOE), DE, (const unsigned*)(ws + WS_LIST), NT, G, c, true, (const float*)(ws + WS_LSCL), (const float*)(ws + WS_CSGU) + layer * NE * 1024};
            pg8::EpiSwiGLUI8 E{};
            pg8::gemm_phase<pg8::EpiSwiGLUI8, pg8::SchedMoE, true, true, 1, true>(lds, 1024, S, E);
            if (layer == 0) late_convert(P, lds, c, G, NT, false);
        });
        SEAM(pb + 4);
        RUN(pb + 5, {
            unsigned char* ws = fresh(args.P.ws);
            const unsigned* cnt = (const unsigned*)(ws + WS_CTL) + CW_CNT + layer * 1024;
            const int NT = pg8::moe_tables(lds, cnt);
            pg8::SchedMoE S{lds, (const char*)(ws + WS_HMOE), (const char*)(ws + WS_WD) + (size_t)layer * NE * 1024 * 512, (size_t)1024 * 512, 512, (bf16*)(ws + WS_Y), 1024, (const unsigned*)(ws + WS_LIST), NT, G, c, false, (const float*)(ws + WS_LSCL), (const float*)(ws + WS_CSD) + layer * NE * 1024};
            pg8::EpiScatterF8 E{};
            pg8::gemm_phase<pg8::EpiScatterF8, pg8::SchedMoE, false, true, 2, true>(lds, 512, S, E);
            if (layer == 0) late_convert(P, lds, c, G, NT, true);
        });
        SEAM(pb + 5);
        RUN(pb + 6, phase_ln2(P, c, G, layer););
        LSEAM(pb + 6);
    }
#undef IN
#undef SEAM
#undef LSEAM
#undef RUN
#undef GBAR
#undef G
#undef c
}

extern "C" void kernel_launch(void* const* d_in, const int* in_sizes, int n_in, void* d_out, int out_size, void* d_ws, size_t ws_size, hipStream_t stream) {
    if (n_in != 20 || ws_size < WS_END) { fprintf(stderr, "kernel_launch: unexpected n_in %d or ws %zu\n", n_in, ws_size); return; }
    Args a{};
    const float** pp = (const float**)&a.P;
    for (int i = 0; i < 20; ++i) pp[i] = (const float*)d_in[i];
    a.P.out = (float*)d_out; a.P.ws = (unsigned char*)d_ws;
    unsigned char* ws = a.P.ws;
    static bool attr = false;
    if (!attr) { (void)hipFuncSetAttribute((const void*)mk_fwd, hipFuncAttributeMaxDynamicSharedMemorySize, LDS_BYTES); attr = true; }
    (void)hipMemsetAsync(ws + WS_CTL, 0, CTL_ZERO_BYTES, stream);
    a.ph_lo = 0; a.ph_hi = 16;
    hipLaunchKernelGGL(mk_fwd, dim3(256), dim3(512), LDS_BYTES, stream, a);
}
```
